# Optimizing an MI355X kernel written in HIP

```python
import math
import jax
import jax.numpy as jnp
from jax import lax
import numpy as np

D_MODEL = 1024
BATCH = 16
SEQ = 4096
DEPTH = 4
DEC_BATCH = 8
DEC_SEQ = 2048
PAST_LEN = 128

N_BRANCH = 4
BR_W = D_MODEL // N_BRANCH
HY_W = BR_W
HY_ORDER = 2
HY_SHORT = 3
HY_BANDS = 16
HY_EMB = 1 + 2 * HY_BANDS
HY_HID = 64
HY_MIN_DECAY = math.log(1e-2) / 1.5
HY_MAX_DECAY = math.log(1e-2) / 0.3
DA_HEADS = 4
DA_HD = BR_W // (2 * DA_HEADS)
QBLK = 128
RET_HEADS = 4
RET_DK = BR_W // (2 * RET_HEADS)
RET_DV = BR_W // RET_HEADS
SSM_HEADS = 4
SSM_P = BR_W // SSM_HEADS
SSM_GROUPS = 2
SSM_N = 64
SSM_CONV = 5
SSM_XBC = BR_W + 2 * SSM_GROUPS * SSM_N
CHUNK = 128
PEER_HEADS = 8
PEER_NK = 128
PEER_N = PEER_NK * PEER_NK
PEER_DK = 128
PEER_TOPK = 16
PEER_TBLK = 128
HY_COLS = 3 * HY_W
DA_COLS = 3 * BR_W
RET_COLS = 2 * RET_HEADS * RET_DK + 2 * BR_W
SSM_COLS = BR_W + SSM_XBC + 2 * SSM_HEADS
IN_COLS = HY_COLS + DA_COLS + RET_COLS + SSM_COLS
IN_SPLITS = (HY_COLS, HY_COLS + DA_COLS, HY_COLS + DA_COLS + RET_COLS)

kernel_name = 'hybrid_bidir_hyena_diffattn_retnet_ssd_peer'


def rmsnorm(x, w, eps=1e-6):
    xf = x.astype(jnp.float32)
    y = xf * lax.rsqrt(jnp.mean(xf * xf, axis=-1, keepdims=True) + eps)
    return (y * w).astype(x.dtype)


def centred_dwconv(x, w, b):
    K, C = w.shape
    y = lax.conv_general_dilated(x, w[:, None, :], window_strides=(1,), padding=[(K // 2, K // 2)],
                                 dimension_numbers=('NWC', 'WIO', 'NWC'), feature_group_count=C)
    return y + b


def chunk_scan(q, k, v, log_a):
    Bsz, L, H, N = q.shape
    P = v.shape[-1]
    nc = L // CHUNK
    qc = q.reshape(Bsz, nc, CHUNK, H, N)
    kc = k.reshape(Bsz, nc, CHUNK, H, N)
    vc = v.reshape(Bsz, nc, CHUNK, H, P)
    cum = jnp.cumsum(log_a.astype(jnp.float32).reshape(Bsz, nc, CHUNK, H), axis=2)
    cum_h = jnp.moveaxis(cum, 3, 2)
    causal = jnp.tril(jnp.ones((CHUNK, CHUNK), dtype=bool))
    seg = jnp.where(causal, cum_h[..., :, None] - cum_h[..., None, :], -jnp.inf)
    scores = jnp.einsum('bcihn,bcjhn->bchij', qc, kc) * jnp.exp(seg)
    y = jnp.einsum('bchij,bcjhp->bcihp', scores, vc)
    to_end = jnp.exp(cum[:, :, -1:, :] - cum)
    chunk_states = jnp.einsum('bcjhn,bcjh,bcjhp->bchnp', kc, to_end, vc)
    chunk_decay = jnp.exp(cum[:, :, -1, :])

    def step(h, inp):
        s, d = inp
        return h * d[..., None, None] + s, h

    h0 = jnp.zeros((Bsz, H, N, P), chunk_states.dtype)
    _, h_prev = lax.scan(step, h0, (jnp.moveaxis(chunk_states, 1, 0), jnp.moveaxis(chunk_decay, 1, 0)))
    h_prev = jnp.moveaxis(h_prev, 0, 1)
    y = y + jnp.einsum('bcihn,bcih,bchnp->bcihp', qc, jnp.exp(cum), h_prev)
    return y.reshape(Bsz, L, H, P)


def bidir_scan(q, k_fwd, k_bwd, v, la_fwd, la_bwd):
    fl = lambda a: jnp.flip(a, axis=1)
    return chunk_scan(q, k_fwd, v, la_fwd) + fl(chunk_scan(fl(q), fl(k_bwd), fl(v), fl(la_bwd)))


def hyena_filters(L, w1, b1, w2, b2, w3, freq):
    f32 = jnp.float32
    pos = jnp.arange(L, dtype=f32)
    t = pos / (L - 1)
    bands = jnp.linspace(1e-4, HY_BANDS - 1, HY_BANDS, dtype=f32)
    ang = (2.0 * math.pi / L) * pos[:, None] * bands[None, :]
    emb = jnp.concatenate([t[:, None], jnp.cos(ang), -jnp.sin(ang)], axis=-1)
    fr = freq.astype(f32)
    hid = jnp.sin(fr * (emb @ w1.astype(f32) + b1.astype(f32)))
    hid = jnp.sin(fr * (hid @ w2.astype(f32) + b2.astype(f32)))
    filt = hid @ w3.astype(f32)
    deltas = jnp.abs(jnp.linspace(HY_MIN_DECAY, HY_MAX_DECAY, HY_W, dtype=f32))
    window = jnp.exp(-t[:, None] * jnp.tile(deltas, HY_ORDER * 2)[None, :])
    filt = filt * window
    filt = filt * lax.rsqrt(jnp.sum(filt * filt, axis=0, keepdims=True) + 1e-6)
    return filt.reshape(L, HY_ORDER, 2, HY_W)


def bidir_fftconv(z, h_fwd, h_bwd, skip):
    L, C = h_fwd.shape
    kern = jnp.concatenate([h_fwd, jnp.zeros((1, C), h_fwd.dtype), h_bwd[:0:-1]], axis=0)
    kf = jnp.fft.rfft(kern, n=2 * L, axis=0)
    zf32 = z.astype(jnp.float32)
    zf = jnp.fft.rfft(zf32, n=2 * L, axis=1)
    y = jnp.fft.irfft(zf * kf[None], n=2 * L, axis=1)[:, :L]
    return (y + zf32 * skip.astype(jnp.float32)).astype(z.dtype)


def hyena_branch(p, P, l):
    L = p.shape[1]
    u = centred_dwconv(p, P['hy_conv_w'][l], P['hy_conv_b'][l])
    v, x1, x2 = jnp.split(u, 3, axis=-1)
    filt = hyena_filters(L, P['hf_w1'][l], P['hf_b1'][l], P['hf_w2'][l], P['hf_b2'][l], P['hf_w3'][l], P['hf_freq'][l])
    z = v
    for o, gate in enumerate((x1, x2)):
        z = gate * bidir_fftconv(z, filt[:, o, 0], filt[:, o, 1], P['hy_bias'][l, o])
    return z


def diffattn_branch(p, P, l):
    f32 = jnp.float32
    B, L, _ = p.shape
    q, k, v = jnp.split(p, 3, axis=-1)
    q = rmsnorm(q.reshape(B, L, DA_HEADS, 2, DA_HD), P['da_qnorm_w'][l]) * (DA_HD ** -0.5)
    k = rmsnorm(k.reshape(B, L, DA_HEADS, 2, DA_HD), P['da_knorm_w'][l])
    v = v.reshape(B, L, DA_HEADS, 2 * DA_HD)
    lam_init = 0.8 - 0.6 * math.exp(-0.3 * l)
    lam = (jnp.exp(jnp.sum(P['da_lq1'][l].astype(f32) * P['da_lk1'][l].astype(f32)))
           - jnp.exp(jnp.sum(P['da_lq2'][l].astype(f32) * P['da_lk2'][l].astype(f32))) + lam_init)
    nblk = L // QBLK
    qb = q.reshape(B, nblk, QBLK, DA_HEADS, 2, DA_HD).transpose(1, 0, 3, 4, 2, 5)
    kt = k.transpose(0, 2, 3, 1, 4)
    vt = v.transpose(0, 2, 1, 3)
    slopes = 2.0 ** (-8.0 * (jnp.arange(DA_HEADS, dtype=f32) + 1.0) / DA_HEADS)
    kpos = jnp.arange(L, dtype=f32)

    def block(args):
        qblk, start = args
        qpos = start.astype(f32) + jnp.arange(QBLK, dtype=f32)
        bias = -slopes[:, None, None] * jnp.abs(qpos[:, None] - kpos[None, :])
        s = jnp.einsum('bhcqd,bhckd->bhcqk', qblk, kt).astype(f32) + bias[None, :, None]
        pr = jax.nn.softmax(s, axis=-1)
        a = pr[:, :, 0] - lam * pr[:, :, 1]
        return jnp.einsum('bhqk,bhkd->bhqd', a.astype(vt.dtype), vt)

    o = lax.map(block, (qb, jnp.arange(nblk) * QBLK))
    o = o.transpose(1, 0, 3, 2, 4).reshape(B, L, DA_HEADS, 2 * DA_HD)
    o = rmsnorm(o, P['da_subln_w'][l].reshape(DA_HEADS, 2 * DA_HD)) * (1.0 - lam_init)
    return o.reshape(B, L, BR_W)


def retention_branch(p, P, l):
    B, L, _ = p.shape
    qk = RET_HEADS * RET_DK
    q, k, v, g = jnp.split(p, [qk, 2 * qk, 2 * qk + BR_W], axis=-1)
    q = q.reshape(B, L, RET_HEADS, RET_DK)
    k = k.reshape(B, L, RET_HEADS, RET_DK) * (RET_DK ** -0.5)
    v = v.reshape(B, L, RET_HEADS, RET_DV)
    hidx = jnp.arange(RET_HEADS, dtype=jnp.float32)
    la_f = jnp.broadcast_to(jnp.log1p(-(2.0 ** (-5.0 - hidx))), (B, L, RET_HEADS))
    la_b = jnp.broadcast_to(jnp.log1p(-(2.0 ** (-5.5 - hidx))), (B, L, RET_HEADS))
    y = bidir_scan(q, k, k, v, la_f, la_b)
    y = rmsnorm(y, P['ret_gn_w'][l].reshape(RET_HEADS, RET_DV)).reshape(B, L, BR_W).astype(p.dtype)
    return jax.nn.silu(g) * y


def ssd_branch(p, P, l):
    B, L, _ = p.shape
    z, xbc, dt = jnp.split(p, [BR_W, BR_W + SSM_XBC], axis=-1)
    xbc = jax.nn.silu(centred_dwconv(xbc, P['ssm_conv_w'][l], P['ssm_conv_b'][l]))
    xs, Bm, Cm = jnp.split(xbc, [BR_W, BR_W + SSM_GROUPS * SSM_N], axis=-1)
    xs = xs.reshape(B, L, SSM_HEADS, SSM_P)
    rep = SSM_HEADS // SSM_GROUPS
    Bh = jnp.repeat(Bm.reshape(B, L, SSM_GROUPS, SSM_N), rep, axis=2)
    Ch = jnp.repeat(Cm.reshape(B, L, SSM_GROUPS, SSM_N), rep, axis=2)
    dt = jax.nn.softplus(dt.astype(jnp.float32).reshape(B, L, 2, SSM_HEADS) + P['ssm_dt_bias'][l])
    A = -jnp.exp(P['ssm_A_log'][l].astype(jnp.float32))
    y = bidir_scan(Ch, Bh * dt[:, :, 0, :, None], Bh * dt[:, :, 1, :, None], xs,
                   dt[:, :, 0] * A[0], dt[:, :, 1] * A[1])
    y = y + P['ssm_D'][l][:, None] * xs
    y = y.reshape(B, L, BR_W).astype(p.dtype) * jax.nn.silu(z)
    return rmsnorm(y, P['ssm_norm_w'][l])


def peer_ffn(h, wq, bq, keys, u, v):
    B, L, D = h.shape
    T = B * L
    ht = h.reshape(T, D)
    q = (ht @ wq + bq).reshape(T, PEER_HEADS, 2, PEER_DK)
    s = jnp.einsum('thcd,hckd->thck', q, keys).astype(jnp.float32)
    s1, i1 = lax.top_k(s[:, :, 0], PEER_TOPK)
    s2, i2 = lax.top_k(s[:, :, 1], PEER_TOPK)
    cand_s = (s1[..., :, None] + s2[..., None, :]).reshape(T, PEER_HEADS, PEER_TOPK * PEER_TOPK)
    cand_i = (i1[..., :, None] * PEER_NK + i2[..., None, :]).reshape(T, PEER_HEADS, PEER_TOPK * PEER_TOPK)
    top_s, pos = lax.top_k(cand_s, PEER_TOPK)
    idx = jnp.take_along_axis(cand_i, pos, axis=-1)
    g = jax.nn.softmax(top_s, axis=-1)
    nb = T // PEER_TBLK
    E = PEER_HEADS * PEER_TOPK

    def block(args):
        xb, ib, gb = args
        act = jax.nn.gelu(jnp.einsum('td,ted->te', xb, u[ib]).astype(jnp.float32), approximate=False)
        return jnp.einsum('te,ted->td', (gb * act).astype(xb.dtype), v[ib])

    out = lax.map(block, (ht.reshape(nb, PEER_TBLK, D), idx.reshape(nb, PEER_TBLK, E), g.reshape(nb, PEER_TBLK, E)))
    return out.reshape(B, L, D)


def encoder_layer(x, c, P, l):
    ada = jax.nn.silu(c) @ P['ada_w'][l] + P['ada_b'][l]
    sh1, sc1, g1, sh2, sc2, g2 = jnp.split(ada[:, None, :], 6, axis=-1)
    h = rmsnorm(x, P['norm1_w'][l]) * (1.0 + sc1) + sh1
    proj = h @ P['w_in'][l]
    p_hy, p_da, p_ret, p_ssm = jnp.split(proj, IN_SPLITS, axis=-1)
    ys = (hyena_branch(p_hy, P, l), diffattn_branch(p_da, P, l),
          retention_branch(p_ret, P, l), ssd_branch(p_ssm, P, l))
    merged = 0.0
    for i in range(N_BRANCH):
        gate = jax.nn.sigmoid(h @ P['w_gate'][l, i] + P['b_gate'][l, i])
        merged = merged + gate * (ys[i] @ P['w_branch'][l, i])
    x = x + g1 * (merged @ P['w_out'][l])
    h2 = rmsnorm(x, P['norm2_w'][l]) * (1.0 + sc2) + sh2
    x = x + g2 * peer_ffn(h2, P['peer_wq'][l], P['peer_bq'][l], P['peer_keys'][l], P['peer_u'][l], P['peer_v'][l])
    return x


def trunk(x, c, P):
    for l in range(DEPTH):
        x = encoder_layer(x, c, P, l)
    return x


def setup_inputs(seed: int = 0) -> dict:
    key = jax.random.key(seed)
    ks = list(jax.random.split(key, 64))

    def nrm(shape, scale):
        return jax.random.normal(ks.pop(), shape, jnp.float32) * scale

    def gain(shape):
        return 1.0 + nrm(shape, 0.01)

    D = D_MODEL
    dt = jnp.exp(jax.random.uniform(ks.pop(), (DEPTH, 2, SSM_HEADS), jnp.float32, math.log(1e-3), math.log(1e-1)))
    a_init = jax.random.uniform(ks.pop(), (DEPTH, 2, SSM_HEADS), jnp.float32, 1.0, 16.0)
    return {
        'x_prompt': nrm((BATCH, SEQ, D), 1.0),
        'x_sample': nrm((DEC_BATCH, DEC_SEQ, D), 1.0),
        'c_prompt': nrm((BATCH, D), 1.0),
        'c_sample': nrm((DEC_BATCH, D), 1.0),
        'ada_w': nrm((DEPTH, D, 6 * D), D ** -0.5),
        'ada_b': nrm((DEPTH, 6 * D), 0.01),
        'norm1_w': gain((DEPTH, D)),
        'norm2_w': gain((DEPTH, D)),
        'w_in': nrm((DEPTH, D, IN_COLS), D ** -0.5),
        'hy_conv_w': nrm((DEPTH, HY_SHORT, HY_COLS), HY_SHORT ** -0.5),
        'hy_conv_b': nrm((DEPTH, HY_COLS), 0.01),
        'hf_w1': nrm((DEPTH, HY_EMB, HY_HID), HY_EMB ** -0.5),
        'hf_b1': nrm((DEPTH, HY_HID), 0.1),
        'hf_w2': nrm((DEPTH, HY_HID, HY_HID), HY_HID ** -0.5),
        'hf_b2': nrm((DEPTH, HY_HID), 0.1),
        'hf_w3': nrm((DEPTH, HY_HID, HY_ORDER * 2 * HY_W), HY_HID ** -0.5),
        'hf_freq': gain((DEPTH, HY_HID)),
        'hy_bias': nrm((DEPTH, HY_ORDER, HY_W), 1.0),
        'da_qnorm_w': gain((DEPTH, DA_HD)),
        'da_knorm_w': gain((DEPTH, DA_HD)),
        'da_lq1': nrm((DEPTH, DA_HD), 0.1),
        'da_lk1': nrm((DEPTH, DA_HD), 0.1),
        'da_lq2': nrm((DEPTH, DA_HD), 0.1),
        'da_lk2': nrm((DEPTH, DA_HD), 0.1),
        'da_subln_w': gain((DEPTH, BR_W)),
        'ret_gn_w': gain((DEPTH, BR_W)),
        'ssm_conv_w': nrm((DEPTH, SSM_CONV, SSM_XBC), SSM_CONV ** -0.5),
        'ssm_conv_b': nrm((DEPTH, SSM_XBC), 0.01),
        'ssm_dt_bias': dt + jnp.log(-jnp.expm1(-dt)),
        'ssm_A_log': jnp.log(a_init),
        'ssm_D': gain((DEPTH, SSM_HEADS)),
        'ssm_norm_w': gain((DEPTH, BR_W)),
        'w_branch': nrm((DEPTH, N_BRANCH, BR_W, D), BR_W ** -0.5),
        'w_gate': nrm((DEPTH, N_BRANCH, D, D), D ** -0.5),
        'b_gate': nrm((DEPTH, N_BRANCH, D), 0.01),
        'w_out': nrm((DEPTH, D, D), D ** -0.5),
        'peer_wq': nrm((DEPTH, D, PEER_HEADS * 2 * PEER_DK), D ** -0.5),
        'peer_bq': nrm((DEPTH, PEER_HEADS * 2 * PEER_DK), 0.01),
        'peer_keys': nrm((DEPTH, PEER_HEADS, 2, PEER_NK, PEER_DK), PEER_DK ** -0.5),
        'peer_u': nrm((DEPTH, PEER_N, D), D ** -0.5),
        'peer_v': nrm((DEPTH, PEER_N, D), 0.5),
    }


def reference(x_prompt, x_sample, c_prompt, c_sample, ada_w, ada_b, norm1_w, norm2_w, w_in,
              hy_conv_w, hy_conv_b, hf_w1, hf_b1, hf_w2, hf_b2, hf_w3, hf_freq, hy_bias,
              da_qnorm_w, da_knorm_w, da_lq1, da_lk1, da_lq2, da_lk2, da_subln_w, ret_gn_w,
              ssm_conv_w, ssm_conv_b, ssm_dt_bias, ssm_A_log, ssm_D, ssm_norm_w,
              w_branch, w_gate, b_gate, w_out, peer_wq, peer_bq, peer_keys, peer_u, peer_v):
    P = dict(ada_w=ada_w, ada_b=ada_b, norm1_w=norm1_w, norm2_w=norm2_w, w_in=w_in,
             hy_conv_w=hy_conv_w, hy_conv_b=hy_conv_b, hf_w1=hf_w1, hf_b1=hf_b1, hf_w2=hf_w2, hf_b2=hf_b2,
             hf_w3=hf_w3, hf_freq=hf_freq, hy_bias=hy_bias, da_qnorm_w=da_qnorm_w, da_knorm_w=da_knorm_w,
             da_lq1=da_lq1, da_lk1=da_lk1, da_lq2=da_lq2, da_lk2=da_lk2, da_subln_w=da_subln_w,
             ret_gn_w=ret_gn_w, ssm_conv_w=ssm_conv_w, ssm_conv_b=ssm_conv_b, ssm_dt_bias=ssm_dt_bias,
             ssm_A_log=ssm_A_log, ssm_D=ssm_D, ssm_norm_w=ssm_norm_w, w_branch=w_branch, w_gate=w_gate,
             b_gate=b_gate, w_out=w_out, peer_wq=peer_wq, peer_bq=peer_bq, peer_keys=peer_keys,
             peer_u=peer_u, peer_v=peer_v)
    y_prompt = trunk(x_prompt, c_prompt, P)
    y_sample = trunk(x_sample, c_sample, P)
    return (y_prompt, y_sample)
```

```cpp
#include <hip/hip_runtime.h>
#include <cstdio>
#include <cstdint>
#include <cstring>
#include <cmath>

#define HD __host__ __device__ __forceinline__
#if defined(__HIP_DEVICE_COMPILE__)
#define DEV_CODE 1
#else
#define DEV_CODE 0
#endif

typedef unsigned short bf16_t;
typedef float f32x4 __attribute__((ext_vector_type(4)));
typedef float f32x2 __attribute__((ext_vector_type(2)));
typedef unsigned u32x4 __attribute__((ext_vector_type(4)));
typedef unsigned u32x2 __attribute__((ext_vector_type(2)));
typedef short bf16x8 __attribute__((ext_vector_type(8)));

HD float u2f(unsigned u) { float f; memcpy(&f, &u, 4); return f; }
HD unsigned f2u(float f) { unsigned u; memcpy(&u, &f, 4); return u; }
HD float bf2f(bf16_t b) { return u2f(((unsigned)b) << 16); }
typedef __bf16 bf16x2_t __attribute__((ext_vector_type(2)));
HD bf16_t f2bf(float f) {
#if DEV_CODE
    const f32x2 v = {f, 0.f}; return (bf16_t)(__builtin_bit_cast(unsigned, __builtin_convertvector(v, bf16x2_t)) & 0xffffu);
#else
    unsigned u = f2u(f); if ((u & 0x7fffffffu) > 0x7f800000u) return (bf16_t)0x7fc0; u += 0x7fffu + ((u >> 16) & 1u); return (bf16_t)(u >> 16);
#endif
}
HD unsigned pack_bf16(float lo, float hi) {
#if DEV_CODE
    const f32x2 v = {lo, hi}; return __builtin_bit_cast(unsigned, __builtin_convertvector(v, bf16x2_t));
#else
    return (unsigned)f2bf(lo) | ((unsigned)f2bf(hi) << 16);
#endif
}
HD float fsinf(float x) {
#if DEV_CODE
    return __builtin_amdgcn_sinf(__builtin_amdgcn_fractf(x * 0.15915494309189535f));
#else
    return sinf(x);
#endif
}
HD float fcosf(float x) {
#if DEV_CODE
    return __builtin_amdgcn_cosf(__builtin_amdgcn_fractf(x * 0.15915494309189535f));
#else
    return cosf(x);
#endif
}
HD float fexpf(float x) {
#if DEV_CODE
    return __builtin_amdgcn_exp2f(x * 1.4426950408889634f);
#else
    return expf(x);
#endif
}
HD float siluf(float x) {
#if DEV_CODE
    return x * __builtin_amdgcn_rcpf(1.0f + __builtin_amdgcn_exp2f(x * -1.4426950408889634f));
#else
    return x / (1.0f + expf(-x));
#endif
}
HD float sigmoidf(float x) {
#if DEV_CODE
    return __builtin_amdgcn_rcpf(1.0f + __builtin_amdgcn_exp2f(x * -1.4426950408889634f));
#else
    return 1.0f / (1.0f + expf(-x));
#endif
}
HD float geluf(float x) { return 0.5f * x * (1.0f + erff(x * 0.70710678118654752f)); }
HD float gelu_as(float v) {
    const float av = fabsf(v), t = 1.0f / (av * 0.2316418882f + 1.0f);
    float q = t * 0.5307027145f - 0.7265760135f; q = q * t + 0.7107068705f; q = q * t - 0.142248368f; q = q * t + 0.127414796f; q = q * t;
    const float m = v * (q * exp2f(v * v * (-0.72134752044f)));
    return v < 0.f ? m : v - m;
}
HD float softplusf(float x) {
#if DEV_CODE
    return x > 20.f ? x : fmaxf(x, 0.f) + __builtin_amdgcn_logf(1.0f + __builtin_amdgcn_exp2f(-fabsf(x) * 1.4426950408889634f)) * 0.6931471805599453f;
#else
    return x > 20.f ? x : log1pf(expf(x));
#endif
}

constexpr int NTHREADS = 512, NTHREADS_ = 512;
constexpr int DM = 1024, NCAT = 7168, NPROJ = 3072, NIN = 3080;
enum { IN_X_PROMPT = 0, IN_X_SAMPLE, IN_C_PROMPT, IN_C_SAMPLE, IN_ADA_W, IN_ADA_B, IN_NORM1_W, IN_NORM2_W, IN_W_IN, IN_HY_CONV_W, IN_HY_CONV_B,
       IN_HF_W1, IN_HF_B1, IN_HF_W2, IN_HF_B2, IN_HF_W3, IN_HF_FREQ, IN_HY_BIAS, IN_DA_QNORM_W, IN_DA_KNORM_W, IN_DA_LQ1, IN_DA_LK1, IN_DA_LQ2, IN_DA_LK2,
       IN_DA_SUBLN_W, IN_RET_GN_W, IN_SSM_CONV_W, IN_SSM_CONV_B, IN_SSM_DT_BIAS, IN_SSM_A_LOG, IN_SSM_D, IN_SSM_NORM_W, IN_W_BRANCH, IN_W_GATE, IN_B_GATE,
       IN_W_OUT, IN_PEER_WQ, IN_PEER_BQ, IN_PEER_KEYS, IN_PEER_U, IN_PEER_V, N_INPUTS };
constexpr int C_HY = 0, C_DAQ = 768, C_DAK = 1024, C_DAV = 1280, C_RQ = 1536, C_RK = 1664, C_RV = 1792, C_RG = 2048, C_SZ = 2304, C_SXBC = 2560;

struct Cfg {
    int depth, n_chunks, nseq_total, n_prompt_seq, n_prompt_tok, Tmax, Lmax, pad0;
    int ck_tok0[8], ck_nseq[8], ck_L[8], ck_seq0[8], ck_li[8];
    int L_len[2];
};
struct Params {
    const float* in[N_INPUTS];
    float* out;
    unsigned* ctl;
    float *ada, *lam, *hid1, *hid2, *filt;
    bf16_t *wcat_t, *wbr_t, *wout_t, *wq_t;
    bf16_t *H, *PROJ, *GATES, *HYU, *HYZ, *XBC, *YS, *MRG;
    float *DT, *RETY, *SSDY, *ATTO, *MRG32, *PG;
    float* DT2;
    bf16_t* XB;
    float *CUM, *DTS, *CSR, *CSS, *keys_t, *fsum, *silu_c;
    bf16_t *HBR, *HBS, *RKT, *RVT, *XT, *keys_bf, *WDT;
    signed char *HQ, *WG8, *WQ8; float *HS, *WGS, *WQS;
    bf16_t *GT, *HYT, *VT;
    unsigned char *PU, *PV; float *PUs, *PVs;
    int* PIDX;
    Cfg cfg;
    int pb, pe;
};

HD const float* x_row_in(const Params& P, int tok) {
    return tok < P.cfg.n_prompt_tok ? P.in[IN_X_PROMPT] + (size_t)tok * DM : P.in[IN_X_SAMPLE] + (size_t)(tok - P.cfg.n_prompt_tok) * DM;
}
HD const float* c_row(const Params& P, int s) {
    return s < P.cfg.n_prompt_seq ? P.in[IN_C_PROMPT] + (size_t)s * DM : P.in[IN_C_SAMPLE] + (size_t)(s - P.cfg.n_prompt_seq) * DM;
}
HD size_t filt_base(const Params& P, int l, int li) { return ((size_t)l * (P.cfg.L_len[0] + P.cfg.L_len[1]) + (li ? P.cfg.L_len[0] : 0)) * 1024; }
HD const float* ada_row(const Params& P, int l, int s) { return P.ada + ((size_t)l * P.cfg.nseq_total + s) * 6144; }

HD void it_wcat(const Params& P, long idx) {
    const int k = idx % DM, n = (idx / DM) % NCAT, l = idx / ((long)DM * NCAT);
    float v;
    if (n < NPROJ) v = P.in[IN_W_IN][((size_t)l * DM + k) * NIN + n];
    else { const int i = (n - NPROJ) >> 10, nn = (n - NPROJ) & 1023; v = P.in[IN_W_GATE][(((size_t)l * 4 + i) * DM + k) * DM + nn]; }
    P.wcat_t[idx] = f2bf(v);
}
HD void it_wbr(const Params& P, long idx) {
    const int k = idx % 256, row = (idx / 256) % 4096, l = idx / (256 * 4096); const int i = row >> 10, n = row & 1023;
    P.wbr_t[idx] = f2bf(P.in[IN_W_BRANCH][(((size_t)l * 4 + i) * 256 + k) * DM + n]);
}
HD void it_wout(const Params& P, long idx) {
    const int k = idx % DM, n = (idx / DM) % DM, l = idx / ((long)DM * DM);
    P.wout_t[idx] = f2bf(P.in[IN_W_OUT][((size_t)l * DM + k) * DM + n]);
}
HD void it_wq(const Params& P, long idx) {
    const int k = idx % DM, n = (idx / DM) % 2048, l = idx / ((long)DM * 2048);
    P.wq_t[idx] = f2bf(P.in[IN_PEER_WQ][((size_t)l * DM + k) * 2048 + n]);
}
HD void it_siluc(const Params& P, long idx) { const int k = idx & 1023, sq = idx >> 10; P.silu_c[idx] = siluf(c_row(P, sq)[k]); }
HD void it_ada(const Params& P, long idx) {
    const int j = idx % 6144, sq = (idx / 6144) % P.cfg.nseq_total, l = idx / (6144 * (long)P.cfg.nseq_total);
    const float* c = P.silu_c + (size_t)sq * DM; const float* w = P.in[IN_ADA_W] + (size_t)l * DM * 6144 + j;
    float acc = 0.f;
    for (int k = 0; k < DM; k += 8) { float wv[8];
#pragma unroll
        for (int e = 0; e < 8; ++e) wv[e] = w[(size_t)(k + e) * 6144];
#pragma unroll
        for (int e = 0; e < 8; ++e) acc += c[k + e] * wv[e]; }
    P.ada[idx] = acc + P.in[IN_ADA_B][l * 6144 + j];
}
HD void it_lam(const Params& P, int l) {
    float s1 = 0.f, s2 = 0.f, mq = 0.f, mk = 0.f;
    for (int d = 0; d < 32; ++d) {
        s1 += P.in[IN_DA_LQ1][l * 32 + d] * P.in[IN_DA_LK1][l * 32 + d]; s2 += P.in[IN_DA_LQ2][l * 32 + d] * P.in[IN_DA_LK2][l * 32 + d];
        mq = fmaxf(mq, fabsf(P.in[IN_DA_QNORM_W][l * 32 + d])); mk = fmaxf(mk, fabsf(P.in[IN_DA_KNORM_W][l * 32 + d]));
    }
    const float lam_init = 0.8f - 0.6f * expf(-0.3f * (float)l);
    P.lam[l * 4 + 0] = expf(s1) - expf(s2) + lam_init; P.lam[l * 4 + 1] = lam_init; P.lam[l * 4 + 2] = 5.656854249f * mq * mk; P.lam[l * 4 + 3] = 0.f;
}
HD void it_hid1(const Params& P, long idx) {
    const int j = idx & 63; const int pos = (idx >> 6) % P.cfg.Lmax; const int li = ((idx >> 6) / P.cfg.Lmax) & 1; const int l = (idx >> 6) / P.cfg.Lmax / 2;
    const int L = P.cfg.L_len[li]; if (pos >= L) return;
    const float* w1 = P.in[IN_HF_W1] + (size_t)l * 33 * 64 + j;
    const float t = (float)pos / (float)(L - 1);
    float acc = t * w1[0];
    const float w0 = 2.0f * 3.14159265358979323846f / (float)L;
    for (int b = 0; b < 16; ++b) {
        const float band = 1e-4f + (float)b * ((15.0f - 1e-4f) / 15.0f);
        const float ang = w0 * (float)pos * band;
        acc += fcosf(ang) * w1[(1 + b) * 64] - fsinf(ang) * w1[(17 + b) * 64];
    }
    P.hid1[idx] = fsinf(P.in[IN_HF_FREQ][l * 64 + j] * (acc + P.in[IN_HF_B1][l * 64 + j]));
}
HD void it_hid2(const Params& P, long idx) {
    const int j = idx & 63; const int pos = (idx >> 6) % P.cfg.Lmax; const int li = ((idx >> 6) / P.cfg.Lmax) & 1; const int l = (idx >> 6) / P.cfg.Lmax / 2;
    if (pos >= P.cfg.L_len[li]) return;
    const float* h1 = P.hid1 + (idx & ~63L); const float* w2 = P.in[IN_HF_W2] + (size_t)l * 64 * 64 + j;
    float acc = 0.f;
    for (int i = 0; i < 64; ++i) acc += h1[i] * w2[i * 64];
    P.hid2[idx] = fsinf(P.in[IN_HF_FREQ][l * 64 + j] * (acc + P.in[IN_HF_B2][l * 64 + j]));
}
HD void it_filt(const Params& P, long idx) {
    const int c4 = idx & 255; const long pr = idx >> 8; const int pos = pr % P.cfg.Lmax; const int li = (pr / P.cfg.Lmax) & 1; const int l = pr / P.cfg.Lmax / 2;
    const int L = P.cfg.L_len[li]; if (pos >= L) return;
    const float* h2 = P.hid2 + pr * 64; const float* w3 = P.in[IN_HF_W3] + (size_t)l * 64 * 1024 + c4 * 4;
    f32x4 acc = {0.f, 0.f, 0.f, 0.f};
    for (int j = 0; j < 64; ++j) acc += *(const f32x4*)(w3 + j * 1024) * h2[j];
    const float t = (float)pos / (float)(L - 1);
    const float mn = -3.0701134573253945f, mx = -15.350567286626972f;
    f32x4 o;
#pragma unroll
    for (int e = 0; e < 4; ++e) { const float delta = fabsf(mn + (float)((c4 * 4 + e) & 255) * ((mx - mn) / 255.0f)); o[e] = acc[e] * expf(-t * delta); }
    *(f32x4*)(P.filt + filt_base(P, l, li) + (size_t)pos * 1024 + c4 * 4) = o;
}
HD void it_fsum(const Params& P, long idx) {
    const int col = idx & 1023, chunk = (idx >> 10) & 63; const int lli = idx >> 16; const int L = P.cfg.L_len[lli & 1], per = L / 64;
    const float* f = P.filt + filt_base(P, lli >> 1, lli & 1) + (size_t)chunk * per * 1024 + col;
    float ss = 0.f;
#pragma unroll 16
    for (int p = 0; p < per; ++p) { const float v = f[(size_t)p * 1024]; ss += v * v; }
    P.fsum[idx] = ss;
}
HD void it_quant_uv(const Params& P, long idx) {
    const long nrow = (long)P.cfg.depth * 16384; const bool isv = idx >= nrow; const long r = isv ? idx - nrow : idx;
    const float* src = P.in[isv ? IN_PEER_V : IN_PEER_U] + r * DM; unsigned char* dst = P.PU + r * 2048 + (isv ? 1024 : 0);
    float amax = 0.f; for (int i = 0; i < DM; ++i) amax = fmaxf(amax, fabsf(src[i]));
    const float sc = amax > 0.f ? amax * (1.0f / 127.0f) : 1.0f, inv = 1.0f / sc;
    for (int i = 0; i < DM; ++i) dst[i] = (unsigned char)(signed char)(int)rintf(src[i] * inv);
    (isv ? P.PVs : P.PUs)[r] = sc;
}

HD void it_norm(const Params& P, int ck, int l, int which, int tl) {
    const int tok = P.cfg.ck_tok0[ck] + tl, s = P.cfg.ck_seq0[ck] + tl / P.cfg.ck_L[ck];
    const float* x = (which == 0 && l == 0) ? x_row_in(P, tok) : P.out + (size_t)tok * DM;
    const float* ad = ada_row(P, l, s) + (which ? 3072 : 0);
    const float* nw = P.in[which ? IN_NORM2_W : IN_NORM1_W] + l * DM;
    float ss = 0.f;
    for (int k = 0; k < DM; ++k) ss += x[k] * x[k];
    const float r = 1.0f / sqrtf(ss * (1.0f / DM) + 1e-6f);
    float dt[8] = {0.f, 0.f, 0.f, 0.f, 0.f, 0.f, 0.f, 0.f};
    const float* wdt = P.in[IN_W_IN] + (size_t)l * DM * NIN + NPROJ;
    bf16_t* h = P.H + (size_t)tl * DM;
    for (int k = 0; k < DM; ++k) {
        const float hv = x[k] * r * nw[k] * (1.0f + ad[1024 + k]) + ad[k];
        h[k] = f2bf(hv);
        if (which == 0) {
#pragma unroll
            for (int j = 0; j < 8; ++j) dt[j] += hv * wdt[(size_t)k * NIN + j];
        }
    }
    if (which == 0) {
#pragma unroll
        for (int j = 0; j < 8; ++j) P.DT[(size_t)tl * 8 + j] = dt[j];
    }
}

HD void it_hyconv(const Params& P, int ck, int l, long idx) {
    const int c = idx % 768; const int tl = idx / 768; const int L = P.cfg.ck_L[ck], t = tl % L, sl = tl / L;
    const float* w = P.in[IN_HY_CONV_W] + (size_t)l * 3 * 768 + c;
    float acc = P.in[IN_HY_CONV_B][l * 768 + c];
#pragma unroll
    for (int j = 0; j < 3; ++j) { const int tt = t + j - 1; if (tt >= 0 && tt < L) acc += w[j * 768] * bf2f(P.PROJ[(size_t)(tl + j - 1) * NPROJ + C_HY + c]); }
    P.HYT[((size_t)sl * 768 + c) * L + t] = f2bf(acc);
}
HD void it_vt(const Params& P, int ck, long idx) {
    const int c = idx & 255; const int tl = idx >> 8; const int L = P.cfg.ck_L[ck];
    P.VT[((size_t)(tl / L) * 256 + c) * L + (tl % L)] = P.PROJ[(size_t)tl * NPROJ + C_DAV + c];
}
HD void it_hyout(const Params& P, int ck, long idx) {
    const int c = idx & 255; const int tl = idx >> 8; const int L = P.cfg.ck_L[ck];
    P.YS[(size_t)tl * DM + c] = P.HYT[((size_t)(tl / L) * 768 + c) * L + (tl % L)];
}
HD void it_xbc(const Params& P, int ck, int l, long idx) {
    const int c = idx & 511; const int tl = idx >> 9; const int L = P.cfg.ck_L[ck], t = tl % L;
    const float* w = P.in[IN_SSM_CONV_W] + (size_t)l * 5 * 512 + c;
    float acc = P.in[IN_SSM_CONV_B][l * 512 + c];
#pragma unroll
    for (int j = 0; j < 5; ++j) { const int tt = t + j - 2; if (tt >= 0 && tt < L) acc += w[j * 512] * bf2f(P.PROJ[(size_t)(tl + j - 2) * NPROJ + C_SXBC + c]); }
    P.XBC[idx] = f2bf(siluf(acc));
}
HD void it_qknorm(const Params& P, int l, long idx) {
    const int sub = idx & 15; const int tl = idx >> 4; const int which = sub >> 3, hc = sub & 7;
    bf16_t* p = P.PROJ + (size_t)tl * NPROJ + (which ? C_DAK : C_DAQ) + hc * 32;
    const float* w = P.in[which ? IN_DA_KNORM_W : IN_DA_QNORM_W] + l * 32;
    u32x4 raw[4]; float v[32]; float ss = 0.f;
#pragma unroll
    for (int i = 0; i < 4; ++i) raw[i] = *(const u32x4*)(p + 8 * i);
#pragma unroll
    for (int i = 0; i < 4; ++i) { const unsigned ww[4] = {raw[i].x, raw[i].y, raw[i].z, raw[i].w};
#pragma unroll
        for (int e = 0; e < 4; ++e) { v[8 * i + 2 * e] = u2f(ww[e] << 16); v[8 * i + 2 * e + 1] = u2f(ww[e] & 0xffff0000u); } }
#pragma unroll
    for (int d = 0; d < 32; ++d) ss += v[d] * v[d];
#if DEV_CODE
    const float r = (1.0f / sqrtf(ss * (1.0f / 32.0f) + 1e-6f)) * (which ? 1.0f : 0.17677669529663687f * 1.4426950408889634f);
#else
    const float r = (1.0f / sqrtf(ss * (1.0f / 32.0f) + 1e-6f)) * (which ? 1.0f : 0.17677669529663687f);
#endif
#pragma unroll
    for (int i = 0; i < 4; ++i) { u32x4 o; o.x = pack_bf16(v[8 * i] * r * w[8 * i], v[8 * i + 1] * r * w[8 * i + 1]); o.y = pack_bf16(v[8 * i + 2] * r * w[8 * i + 2], v[8 * i + 3] * r * w[8 * i + 3]);
        o.z = pack_bf16(v[8 * i + 4] * r * w[8 * i + 4], v[8 * i + 5] * r * w[8 * i + 5]); o.w = pack_bf16(v[8 * i + 6] * r * w[8 * i + 6], v[8 * i + 7] * r * w[8 * i + 7]);
        *(u32x4*)(p + 8 * i) = o; }
}

constexpr int SCK = 64;
HD float ret_la(int dir, int head) {
#if DEV_CODE
    const float e = __builtin_amdgcn_exp2f(-(dir ? 5.5f : 5.0f) - (float)head);
    return -e * (1.0f + e * (0.5f + e * (0.33333333f + e * (0.25f + e * (0.2f + e * 0.16666667f)))));
#else
    return log1pf(-exp2f(-(dir ? 5.5f : 5.0f) - (float)head));
#endif
}
HD size_t cum_idx(const Params& P, int ty, int d, int sl, int h, int t, int L) { return ((size_t)(ty * 2 + d) * 4 * P.cfg.Tmax) + (size_t)(sl * 4 + h) * L + t; }
HD void it_cum(const Params& P, int ck, int l, long idx) {
    const int L = P.cfg.ck_L[ck], nchunk = L / SCK, nseq = P.cfg.ck_nseq[ck];
    const int h = idx & 3; const int c = (idx >> 2) % nchunk; const int sl = ((idx >> 2) / nchunk) % nseq; const int d = ((idx >> 2) / nchunk / nseq) & 1; const int ty = (idx >> 2) / nchunk / nseq / 2;
    float* cum = P.CUM + cum_idx(P, ty, d, sl, h, c * SCK, L);
    if (ty == 0) { const float la = ret_la(d, h); for (int jj = 0; jj < SCK; ++jj) cum[jj] = (float)(d ? SCK - jj : jj + 1) * la; return; }
    const float A = -expf(P.in[IN_SSM_A_LOG][l * 8 + d * 4 + h]); const float dtb = P.in[IN_SSM_DT_BIAS][l * 8 + d * 4 + h];
    float* dts = P.DTS + cum_idx(P, 0, d, sl, h, c * SCK, L); float run = 0.f;
    for (int k = 0; k < SCK; ++k) { const int jj = d ? SCK - 1 - k : k; const size_t tl = (size_t)sl * L + c * SCK + jj;
        const float dt = softplusf(P.DT[tl * 8 + d * 4 + h] + dtb); run += dt * A; cum[jj] = run; dts[jj] = dt; }
}
HD void it_scan_tr(const Params& P, int ck, long idx) {
    const int c = idx % 768; const int tl = idx / 768; const int L = P.cfg.ck_L[ck], sl = tl / L, t = tl % L;
    if (c < 128) P.RKT[((size_t)sl * 128 + c) * L + t] = P.PROJ[(size_t)tl * NPROJ + C_RK + c];
    else if (c < 384) P.RVT[((size_t)sl * 256 + (c - 128)) * L + t] = P.PROJ[(size_t)tl * NPROJ + C_RV + (c - 128)];
    else P.XT[((size_t)sl * 384 + (c - 384)) * L + t] = P.XBC[(size_t)tl * 512 + (c - 384)];
}
HD const bf16_t* sc_qrow(const Params& P, int ty, int h, size_t tl) { return ty ? P.XBC + tl * 512 + 384 + (h >> 1) * 64 : P.PROJ + tl * NPROJ + C_RQ + h * 32; }
HD const bf16_t* sc_krow(const Params& P, int ty, int h, size_t tl) { return ty ? P.XBC + tl * 512 + 256 + (h >> 1) * 64 : P.PROJ + tl * NPROJ + C_RK + h * 32; }
HD const bf16_t* sc_kT(const Params& P, int ty, int sl, int h, int n, int L) { return ty ? P.XT + ((size_t)sl * 384 + 256 + (h >> 1) * 64 + n) * L : P.RKT + ((size_t)sl * 128 + h * 32 + n) * L; }
HD const bf16_t* sc_vT(const Params& P, int ty, int sl, int h, int p, int L) { return ty ? P.XT + ((size_t)sl * 384 + h * 64 + p) * L : P.RVT + ((size_t)sl * 256 + h * 64 + p) * L; }
HD size_t sc_unit(int d, int sl, int c, int h, int nseq, int nchunk) { return (((size_t)(d * nseq + sl) * nchunk + c) * 4 + h); }
template <int G> HD void scan_prefix_g(const Params& P, int ck, int ty, long idx) {
    const int L = P.cfg.ck_L[ck], nchunk = L / SCK, nseq = P.cfg.ck_nseq[ck]; const int N = ty ? 64 : 32;
    const int pn = idx & (N * 64 - 1); const long r = idx >> (ty ? 12 : 11); const int h = r & 3; const int sl = (r >> 2) % nseq; const int d = (r >> 2) / nseq;
    const float* cs = (ty ? P.CSS : P.CSR); bf16_t* hb = (ty ? P.HBS : P.HBR); float H = 0.f;
    for (int k0 = 0; k0 < nchunk; k0 += G) {
        float cv[G], dc[G];
#pragma unroll
        for (int j = 0; j < G; ++j) { const int c = d ? nchunk - 1 - (k0 + j) : k0 + j;
            cv[j] = cs[sc_unit(d, sl, c, h, nseq, nchunk) * (N * 64) + pn]; dc[j] = P.CUM[cum_idx(P, ty, d, sl, h, c * SCK + (d ? 0 : SCK - 1), L)]; }
#pragma unroll
        for (int j = 0; j < G; ++j) { const int c = d ? nchunk - 1 - (k0 + j) : k0 + j; hb[sc_unit(d, sl, c, h, nseq, nchunk) * (N * 64) + pn] = f2bf(H); H = H * fexpf(dc[j]) + cv[j]; }
    }
}
HD void it_scan_prefix(const Params& P, int ck, int ty, long idx) {
    if ((P.cfg.ck_L[ck] / SCK) % 16 == 0) scan_prefix_g<16>(P, ck, ty, idx); else scan_prefix_g<4>(P, ck, ty, idx);
}

HD void it_attn(const Params& P, int ck, int l, long idx) {
    const int L = P.cfg.ck_L[ck]; const int t = idx % L; const int r = idx / L; const int vh = r & 1, head = (r >> 1) & 3, sl = r >> 3;
    const float lam = P.lam[l * 4 + 0], M = P.lam[l * 4 + 2]; const float slope = exp2f(-2.0f * (float)(head + 1));
    const size_t tl = (size_t)sl * L + t;
    float q1[32], q2[32], o1[32], o2[32];
    { const bf16_t* qp = P.PROJ + tl * NPROJ + C_DAQ + head * 64;
#pragma unroll
      for (int d = 0; d < 32; ++d) { q1[d] = bf2f(qp[d]); q2[d] = bf2f(qp[32 + d]); o1[d] = 0.f; o2[d] = 0.f; } }
    float l1 = 0.f, l2 = 0.f;
    for (int j = 0; j < L; ++j) {
        const bf16_t* kr = P.PROJ + ((size_t)sl * L + j) * NPROJ;
        const bf16_t* kp = kr + C_DAK + head * 64; const bf16_t* vp = kr + C_DAV + head * 64 + vh * 32;
        float s1 = 0.f, s2 = 0.f;
#pragma unroll
        for (int d = 0; d < 32; ++d) { s1 += q1[d] * bf2f(kp[d]); s2 += q2[d] * bf2f(kp[32 + d]); }
        const float bias = -slope * fabsf((float)(t - j)) - M;
        const float e1 = expf(s1 + bias), e2 = expf(s2 + bias);
        l1 += e1; l2 += e2;
#pragma unroll
        for (int d = 0; d < 32; ++d) { const float v = bf2f(vp[d]); o1[d] += e1 * v; o2[d] += e2 * v; }
    }
    const float r1 = 1.0f / l1, r2 = lam / l2;
    float* o = P.ATTO + tl * 256 + head * 64 + vh * 32;
#pragma unroll
    for (int d = 0; d < 32; ++d) o[d] = o1[d] * r1 - o2[d] * r2;
}

HD size_t gt_base(const Params& P, int l, int li, int oc) { const size_t x0 = 2 * (size_t)P.cfg.L_len[0] + 32, x1 = 2 * (size_t)P.cfg.L_len[1] + 32; return ((size_t)l * 512 + oc) * (x0 + x1) + (li ? x0 : 0); }
HD void it_gt(const Params& P, long idx) {
    const int NGX = (2 * P.cfg.Lmax + 32) / 16; const int oc = idx & 511; const long r = idx >> 9; const int xg = r % NGX; const int li = (r / NGX) & 1, l = r / NGX / 2;
    const int L = P.cfg.L_len[li]; const int x0 = xg * 16; if (x0 >= 2 * L + 32) return;
    const int o = oc >> 8, c = oc & 255; const int d0 = L + 15 - x0;
    const bool fwd = d0 >= 15; const int col = o * 512 + (fwd ? 0 : 256) + c;
    const float* fs = P.fsum + (size_t)(l * 2 + li) * 65536 + col; float ss = 0.f;
    for (int k = 0; k < 64; ++k) ss += fs[k * 1024];
    const float sc = 1.0f / sqrtf(ss + 1e-6f); const float* f = P.filt + filt_base(P, l, li) + col;
    float v[16];
#pragma unroll
    for (int j = 0; j < 16; ++j) { const int d = d0 - j; const int ad = d >= 0 ? d : -d; v[j] = ad < L ? f[(size_t)ad * 1024] * sc : 0.f; }
    u32x4 w0, w1;
    w0.x = pack_bf16(v[0], v[1]); w0.y = pack_bf16(v[2], v[3]); w0.z = pack_bf16(v[4], v[5]); w0.w = pack_bf16(v[6], v[7]);
    w1.x = pack_bf16(v[8], v[9]); w1.y = pack_bf16(v[10], v[11]); w1.z = pack_bf16(v[12], v[13]); w1.w = pack_bf16(v[14], v[15]);
    bf16_t* dst = P.GT + gt_base(P, l, li, oc) + x0; *(u32x4*)dst = w0; *(u32x4*)(dst + 8) = w1;
}
HD int hy_afrag_x0(int L, int m, int lane) { const int i = lane & 15, q = lane >> 4; return L + 15 - (16 * (2 * m + (q >> 1)) + i - 8 * (q & 1)); }
HD int hy_bfrag_pos(int ct, int m, int lane) { const int col = lane & 15, q = lane >> 4; return 256 * ct + 16 * col - 32 * m - 16 * (q >> 1) + 8 * (q & 1); }
HD void hy_mrange(int L, int ct, int& m_lo, int& m_hi) { const int lo = 16 * ct - (L / 16 - 1), hi = 16 * ct + 15; m_lo = (lo >= 0 ? lo : lo - 1) / 2; m_hi = hi / 2; }
constexpr int HY_PAD = 256;

HD void it_attnpost(const Params& P, int l, long idx) {
    const int head = idx & 3; const size_t tl = idx >> 2; const float* o = P.ATTO + tl * 256 + head * 64;
    float ss = 0.f;
    for (int d = 0; d < 64; ++d) ss += o[d] * o[d];
    const float r = (1.0f / sqrtf(ss * (1.0f / 64.0f) + 1e-6f)) * (1.0f - P.lam[l * 4 + 1]);
    const float* w = P.in[IN_DA_SUBLN_W] + l * 256 + head * 64;
    for (int d = 0; d < 64; ++d) P.YS[tl * DM + 256 + head * 64 + d] = f2bf(o[d] * r * w[d]);
}
HD void it_retpost(const Params& P, int l, long idx) {
    const int head = idx & 3; const size_t tl = idx >> 2;
    const float* y0 = P.RETY + tl * 256 + head * 64; const float* y1 = y0 + (size_t)P.cfg.Tmax * 256;
    float ss = 0.f;
    for (int d = 0; d < 64; ++d) { const float y = y0[d] + y1[d]; ss += y * y; }
    const float r = 1.0f / sqrtf(ss * (1.0f / 64.0f) + 1e-6f);
    const float* w = P.in[IN_RET_GN_W] + l * 256 + head * 64; const bf16_t* g = P.PROJ + tl * NPROJ + C_RG + head * 64;
    for (int d = 0; d < 64; ++d) P.YS[tl * DM + 512 + head * 64 + d] = f2bf((y0[d] + y1[d]) * r * w[d] * siluf(bf2f(g[d])));
}
HD void it_ssdpost(const Params& P, int l, long idx) {
    const size_t tl = idx; const float* y0 = P.SSDY + tl * 256; const float* y1 = y0 + (size_t)P.cfg.Tmax * 256;
    const bf16_t* xs = P.XBC + tl * 512; const bf16_t* z = P.PROJ + tl * NPROJ + C_SZ; const float* Dp = P.in[IN_SSM_D] + l * 4;
    float ss = 0.f;
    for (int c = 0; c < 256; ++c) { const float y = (y0[c] + y1[c] + Dp[c >> 6] * bf2f(xs[c])) * siluf(bf2f(z[c])); ss += y * y; }
    const float r = 1.0f / sqrtf(ss * (1.0f / 256.0f) + 1e-6f); const float* w = P.in[IN_SSM_NORM_W] + l * 256;
    for (int c = 0; c < 256; ++c) { const float y = (y0[c] + y1[c] + Dp[c >> 6] * bf2f(xs[c])) * siluf(bf2f(z[c])); P.YS[tl * DM + 768 + c] = f2bf(y * r * w[c]); }
}

HD void it_keys_t(const Params& P, long idx) {
    const int key = idx & 127, d = (idx >> 7) & 127; const long lh = idx >> 14;
    P.keys_t[idx] = P.in[IN_PEER_KEYS][(lh * 128 + key) * 128 + d];
}
HD void it_wdt(const Params& P, long idx) {
    const int k = idx & 1023, j = (idx >> 10) & 15, l = idx >> 14; P.WDT[idx] = j < 8 ? f2bf(P.in[IN_W_IN][((size_t)l * DM + k) * NIN + NPROJ + j]) : (bf16_t)0;
}
HD void it_keys_bf(const Params& P, long idx) { P.keys_bf[idx] = f2bf(P.in[IN_PEER_KEYS][idx]); }
HD void it_pscore(const Params& P, int l, long idx) {
    const int k4 = idx & 31, hc = (idx >> 5) & 15; const size_t tl = idx >> 9;
    const bf16_t* q = P.PROJ + tl * 2048 + hc * 128; const float* kt = P.keys_t + (((size_t)l * 16 + hc) * 128) * 128 + k4 * 4;
    f32x4 acc = {0.f, 0.f, 0.f, 0.f};
    for (int d = 0; d < 128; ++d) acc += *(const f32x4*)(kt + d * 128) * bf2f(q[d]);
    *(f32x4*)((float*)P.GATES + tl * 2048 + hc * 128 + k4 * 4) = acc;
}
#define TOPK_INSERT(v, ix, x, xi) do { _Pragma("unroll") for (int _k = 15; _k >= 1; --_k) { const bool gp = (x) > v[_k - 1], gc = (x) > v[_k]; \
        v[_k] = gp ? v[_k - 1] : (gc ? (x) : v[_k]); ix[_k] = gp ? ix[_k - 1] : (gc ? (xi) : ix[_k]); } \
        { const bool g0 = (x) > v[0]; v[0] = g0 ? (x) : v[0]; ix[0] = g0 ? (xi) : ix[0]; } } while (0)
HD void it_ptopk(const Params& P, long idx) {
    const int h = idx & 7; const size_t tl = idx >> 3;
    const float* s = (const float*)P.GATES + tl * 2048 + h * 256;
    float v1[16], v2[16], vt[16]; int i1[16], i2[16], it[16];
#pragma unroll
    for (int k = 0; k < 16; ++k) { v1[k] = -3.0e38f; v2[k] = -3.0e38f; vt[k] = -3.0e38f; i1[k] = 0; i2[k] = 0; it[k] = 0; }
    for (int k = 0; k < 128; ++k) { const float x = s[k]; TOPK_INSERT(v1, i1, x, k); }
    for (int k = 0; k < 128; ++k) { const float x = s[128 + k]; TOPK_INSERT(v2, i2, x, k); }
#pragma unroll
    for (int a = 0; a < 16; ++a) {
#pragma unroll
        for (int b = 0; b < 16; ++b) { const float x = v1[a] + v2[b]; const int xi = i1[a] * 128 + i2[b]; TOPK_INSERT(vt, it, x, xi); }
    }
    float den = 0.f, e[16];
#pragma unroll
    for (int k = 0; k < 16; ++k) { e[k] = expf(vt[k] - vt[0]); den += e[k]; }
    const float rd = 1.0f / den;
#pragma unroll
    for (int k = 0; k < 16; ++k) { P.PIDX[tl * 128 + h * 16 + k] = it[k]; P.PG[tl * 128 + h * 16 + k] = e[k] * rd; }
}
HD void it_peer_a(const Params& P, int l, long idx) {
    const int part = idx & 15; const size_t te = idx >> 4; const size_t tl = te >> 7;
    const int ex = P.PIDX[te]; const signed char* u = (const signed char*)P.PU + ((size_t)l * 16384 + ex) * 2048 + part * 4; const bf16_t* hrow = P.H + tl * DM; const float sc = P.PUs[(size_t)l * 16384 + ex];
    float hmax = 0.f; for (int i = 0; i < DM; ++i) hmax = fmaxf(hmax, fabsf(bf2f(hrow[i])));
    const float hinv = hmax > 0.f ? 127.0f / hmax : 0.f; const bf16_t* h = hrow + part * 4;
    int acc = 0;
    for (int i = 0; i < 16; ++i) { const signed char* up = u + 64 * i; const bf16_t* hp = h + 64 * i;
        for (int j = 0; j < 4; ++j) acc += (int)rintf(bf2f(hp[j]) * hinv) * (int)up[j]; }
    ((float*)P.GATES)[idx] = (float)acc * sc * (hmax * (1.0f / 127.0f));
}
HD void it_peer_b0(const Params& P, long idx) {
    const float* pp = (const float*)P.GATES + idx * 16; float s = 0.f;
#pragma unroll
    for (int i = 0; i < 16; ++i) s += pp[i];
    P.PG[idx] = P.PG[idx] * geluf(s);
}
HD void it_peer_b(const Params& P, int ck, int l, long idx) {
    const int d4 = idx & 255; const int tl = idx >> 8; const int tok = P.cfg.ck_tok0[ck] + tl, s = P.cfg.ck_seq0[ck] + tl / P.cfg.ck_L[ck];
    const float* coef = P.PG + (size_t)tl * 128; const int* ix = P.PIDX + (size_t)tl * 128; const signed char* V = (const signed char*)P.PU + (size_t)l * 16384 * 2048 + 1024 + d4 * 4;
    float c[128], cmax = 0.f;
    for (int e = 0; e < 128; ++e) { c[e] = coef[e] * P.PVs[(size_t)l * 16384 + ix[e]]; cmax = fmaxf(cmax, fabsf(c[e])); }
    const float cinv = cmax > 0.f ? 127.0f / cmax : 0.f; int acc[4] = {0, 0, 0, 0};
    for (int e = 0; e < 128; ++e) { const signed char* v = V + (size_t)ix[e] * 2048; const int cq = (int)rintf(c[e] * cinv); for (int j = 0; j < 4; ++j) acc[j] += cq * (int)v[j]; }
    const float csc = cmax * (1.0f / 127.0f);
    const f32x4 accf = {(float)acc[0] * csc, (float)acc[1] * csc, (float)acc[2] * csc, (float)acc[3] * csc};
    const f32x4 g2 = *(const f32x4*)(ada_row(P, l, s) + 5120 + d4 * 4);
    f32x4* xo = (f32x4*)(P.out + (size_t)tok * DM + d4 * 4);
    *xo = *xo + g2 * accf;
}

namespace pg8 {
#define PG8_LAS __attribute__((address_space(3)))
constexpr int BM = 256, BK = 64, HALF = 128, HTB = HALF * BK * 2, STAGE_BYTES = 8 * HTB, NXCD = 8, WGM = 8;
HD int lds_byte(int r, int c) { const int st = (r >> 4) * 2 + (c >> 5), rr = r & 15, cc = c & 31, ob = rr * 64 + cc * 2; return st * 1024 + (ob ^ (((ob >> 9) & 1) << 5)); }
HD void stage_rc(int b, int& R, int& C) { const int st = b / 1024, sb = b % 1024, swz = sb ^ (((sb >> 9) & 1) << 5); R = (st >> 1) * 16 + swz / 64; C = (st & 1) * 32 + (swz % 64) / 2; }
HD int perm32(int rho) { const int n = rho >> 4, i = rho & 15; return 8 * (i >> 2) + 4 * n + (i & 3); }
struct Unit { int pm, pn; };
struct Gemm { const bf16_t* A; const bf16_t* Bt; int M, N, K, lda; const float* rs; const float* cs; };
struct StaticOrder {
    int nM, nN, nwg, G, c;
    HD void init(int M, int N, int G_, int c_) { nM = M / BM; nN = N / BM; nwg = nM * nN; G = G_; c = c_; }
    HD bool next(int i, Unit& u) const {
        const long L = (long)i * G + c; if (L >= nwg) return false;
        int wgid = (int)L; { const int q = nwg / NXCD, r = nwg % NXCD, xcd = wgid % NXCD, off = wgid / NXCD; wgid = (xcd < r ? xcd * (q + 1) : r * (q + 1) + (xcd - r) * q) + off; }
        const int nig = WGM * nN, gid = wgid / nig, fm = gid * WGM, gsz = (nM - fm) < WGM ? (nM - fm) : WGM;
        u.pm = fm + ((wgid % nig) % gsz); u.pn = (wgid % nig) / gsz; return true;
    }
    HD size_t a_off(const Unit&) const { return 0; }
};
struct BranchOrder {
    int nM, G, c;
    HD void init(int M, int G_, int c_) { nM = M / BM; G = G_; c = c_; }
    HD bool next(int i, Unit& u) const { const int cs = (G & 7) == 0 ? (c & 7) * (G >> 3) + (c >> 3) : c;
        const long tile = (long)(i >> 2) * G + cs; if (tile >= (long)nM * 4) return false; u.pm = (int)(tile >> 2); u.pn = (i & 3) * 4 + (int)(tile & 3); return true; }
    HD size_t a_off(const Unit& u) const { return (size_t)(u.pn >> 2) * 256 * 2; }
};

struct EpiCat {
    static constexpr bool PERM = true;
    bf16_t* proj; unsigned char* gates; const float* bgate; int pn_base; const float* rs; const float* cs;
    HD void operator()(const f32x4 (&acc)[2][2][4][2], const Unit& u, int wr, int wc, int fr, int fq) const {
        typedef int i32x4_ __attribute__((ext_vector_type(4)));
        const bool isg = pn_base >= 12;
        const int row0 = u.pm * BM + wr * 64 + fr; const int col0 = u.pn * BM + wc * 32 + 8 * fq;
#pragma unroll
        for (int bj = 0; bj < 2; ++bj) {
            f32x4 b0 = {0.f, 0.f, 0.f, 0.f}, b1 = b0, c0 = {1.f, 1.f, 1.f, 1.f}, c1 = c0;
            if (isg) { b0 = *(const f32x4*)(bgate + col0 + bj * HALF); b1 = *(const f32x4*)(bgate + col0 + bj * HALF + 4); }
            if (cs) { c0 = *(const f32x4*)(cs + col0 + bj * HALF); c1 = *(const f32x4*)(cs + col0 + bj * HALF + 4); }
#pragma unroll
            for (int ai = 0; ai < 2; ++ai)
#pragma unroll
                for (int m = 0; m < 4; ++m) { const size_t row = (size_t)(row0 + ai * HALF + m * 16); f32x4 v0, v1;
                    if (cs) { const float r = rs[row]; v0 = __builtin_convertvector(__builtin_bit_cast(i32x4_, acc[ai][bj][m][0]), f32x4) * (c0 * r) + b0; v1 = __builtin_convertvector(__builtin_bit_cast(i32x4_, acc[ai][bj][m][1]), f32x4) * (c1 * r) + b1; }
                    else { v0 = acc[ai][bj][m][0] + b0; v1 = acc[ai][bj][m][1] + b1; }
                    if (isg) { u32x2 w; unsigned q[8];
#pragma unroll
                        for (int j = 0; j < 4; ++j) { q[j] = (unsigned)(int)(sigmoidf(v0[j]) * 255.0f + 0.5f); q[4 + j] = (unsigned)(int)(sigmoidf(v1[j]) * 255.0f + 0.5f); }
                        w.x = q[0] | (q[1] << 8) | (q[2] << 16) | (q[3] << 24); w.y = q[4] | (q[5] << 8) | (q[6] << 16) | (q[7] << 24);
                        *(u32x2*)(gates + row * 4096 + col0 + bj * HALF) = w; }
                    else { u32x4 w; w.x = pack_bf16(v0[0], v0[1]); w.y = pack_bf16(v0[2], v0[3]); w.z = pack_bf16(v1[0], v1[1]); w.w = pack_bf16(v1[2], v1[3]);
                        *(u32x4*)(proj + row * NPROJ + col0 + bj * HALF) = w; } }
        }
    }
};
struct EpiBranch {
    static constexpr bool PERM = true;
    float* mrg32; bf16_t* mrg; const unsigned char* gates;
    template <bool RMW>
    HD void run(const f32x4 (&acc)[2][2][4][2], const unsigned char* gb, const unsigned row0, const unsigned col0) const {
        constexpr int EB_D = 6;
        u32x2 gw[16]; u32x4 mw[16];
#define EB_ROW(s) (row0 + (unsigned)(((s) >> 3) * HALF + (((s) >> 1) & 3) * 16))
#define EB_COL(s) (col0 + (unsigned)(((s) & 1) * HALF))
#pragma unroll
        for (int st = 0; st < EB_D; ++st) { gw[st] = *(const u32x2*)(gb + (EB_ROW(st) * 4096u + EB_COL(st))); if (RMW) mw[st] = *(const u32x4*)(mrg + (EB_ROW(st) * (unsigned)DM + EB_COL(st))); }
#pragma unroll
        for (int st = 0; st < 16; ++st) {
            if (st + EB_D < 16) { gw[(st + EB_D) & 15] = *(const u32x2*)(gb + (EB_ROW(st + EB_D) * 4096u + EB_COL(st + EB_D))); if (RMW) mw[(st + EB_D) & 15] = *(const u32x4*)(mrg + (EB_ROW(st + EB_D) * (unsigned)DM + EB_COL(st + EB_D))); }
#if DEV_CODE
            asm volatile("" ::: "memory");
#endif
            const int ai = st >> 3, m = (st >> 1) & 3, bj = st & 1; const float k255 = 1.0f / 255.0f; const u32x2 g = gw[st];
            f32x4 g0 = {(float)(g.x & 0xffu) * k255, (float)((g.x >> 8) & 0xffu) * k255, (float)((g.x >> 16) & 0xffu) * k255, (float)(g.x >> 24) * k255};
            f32x4 g1 = {(float)(g.y & 0xffu) * k255, (float)((g.y >> 8) & 0xffu) * k255, (float)((g.y >> 16) & 0xffu) * k255, (float)(g.y >> 24) * k255};
            f32x4 v0 = acc[ai][bj][m][0] * g0, v1 = acc[ai][bj][m][1] * g1;
            if (RMW) { const u32x4 w = mw[st];
                v0 += (f32x4){u2f(w.x << 16), u2f(w.x & 0xffff0000u), u2f(w.y << 16), u2f(w.y & 0xffff0000u)}; v1 += (f32x4){u2f(w.z << 16), u2f(w.z & 0xffff0000u), u2f(w.w << 16), u2f(w.w & 0xffff0000u)}; }
            u32x4 w; w.x = pack_bf16(v0[0], v0[1]); w.y = pack_bf16(v0[2], v0[3]); w.z = pack_bf16(v1[0], v1[1]); w.w = pack_bf16(v1[2], v1[3]);
            *(u32x4*)(mrg + (EB_ROW(st) * (unsigned)DM + EB_COL(st))) = w;
        }
#undef EB_ROW
#undef EB_COL
    }
    HD void operator()(const f32x4 (&acc)[2][2][4][2], const Unit& u, int wr, int wc, int fr, int fq) const {
        const int br = u.pn >> 2, jt = u.pn & 3; const unsigned row0 = u.pm * BM + wr * 64 + fr; const unsigned col0 = jt * BM + wc * 32 + 8 * fq;
        const unsigned char* gb = gates + br * 1024;
        if (br > 0) run<true>(acc, gb, row0, col0); else run<false>(acc, gb, row0, col0);
    }
};
#ifdef HOST_TEST
struct EpiOut {
    static constexpr bool PERM = false;
    const float* xin_p; const float* xin_s; float* xout; const float* ada_l; int tok0, seq0, L, n_prompt_tok;
    HD void operator()(const f32x4 (&acc)[2][2][4][2], const Unit& u, int wr, int wc, int fr, int fq) const {
        constexpr int EO_D = 2;
        const int row0 = u.pm * BM + wr * 64 + fr, col0 = u.pn * BM + wc * 32 + 4 * fq;
        const float* g1 = ada_l + (size_t)(seq0 + (u.pm * BM) / L) * 6144 + 2048;
        const bool smp = xin_s && (tok0 + u.pm * BM >= n_prompt_tok);
        const float* xb = smp ? xin_s + (size_t)(tok0 - n_prompt_tok) * DM : xin_p + (size_t)tok0 * DM;
        f32x4 gv[2][2], xv[8][2][2];
#pragma unroll
        for (int bj = 0; bj < 2; ++bj)
#pragma unroll
            for (int n = 0; n < 2; ++n) gv[bj][n] = *(const f32x4*)(g1 + col0 + bj * HALF + n * 16);
#define EO_ROW(s) (row0 + ((s) >> 2) * HALF + ((s) & 3) * 16)
#define EO_LOAD(s) do { _Pragma("unroll") for (int bj = 0; bj < 2; ++bj) _Pragma("unroll") for (int n = 0; n < 2; ++n) xv[(s) & 7][bj][n] = *(const f32x4*)(xb + (size_t)EO_ROW(s) * DM + col0 + bj * HALF + n * 16); } while (0)
#pragma unroll
        for (int st = 0; st < EO_D; ++st) EO_LOAD(st);
#pragma unroll
        for (int st = 0; st < 8; ++st) {
            if (st + EO_D < 8) EO_LOAD(st + EO_D);
#if DEV_CODE
            asm volatile("" ::: "memory");
#endif
            const int ai = st >> 2, m = st & 3; float* xo = xout + (size_t)(tok0 + EO_ROW(st)) * DM;
#pragma unroll
            for (int bj = 0; bj < 2; ++bj)
#pragma unroll
                for (int n = 0; n < 2; ++n) *(f32x4*)(xo + col0 + bj * HALF + n * 16) = xv[st][bj][n] + gv[bj][n] * acc[ai][bj][m][n];
        }
#undef EO_ROW
#undef EO_LOAD
    }
};
#else
struct EpiOut {
    static constexpr bool PERM = true;
    const float* xin_p; const float* xin_s; bf16_t* xb; const float* ada_l; int tok0, seq0, L, n_prompt_tok;
    template <bool L0>
    HD void run(const f32x4 (&acc)[2][2][4][2], const Unit& u, int wr, int wc, int fr, int fq) const {
        constexpr int EO_D = L0 ? 1 : 2;
        const int row0 = u.pm * BM + wr * 64 + fr, col0 = u.pn * BM + wc * 32 + 8 * fq;
        const float* g1 = ada_l + (size_t)(seq0 + (u.pm * BM) / L) * 6144 + 2048;
        const bool smp = tok0 + u.pm * BM >= n_prompt_tok;
        const float* xf = L0 ? (smp ? xin_s + (size_t)(tok0 - n_prompt_tok) * DM : xin_p + (size_t)tok0 * DM) : nullptr;
        f32x4 gv[2][2]; f32x4 xv[8][2][2]; u32x4 xw[8][2];
#pragma unroll
        for (int bj = 0; bj < 2; ++bj)
#pragma unroll
            for (int n = 0; n < 2; ++n) gv[bj][n] = *(const f32x4*)(g1 + col0 + bj * HALF + n * 4);
#define EO_ROW(s) (row0 + ((s) >> 2) * HALF + ((s) & 3) * 16)
#define EO_LOAD(s) do { _Pragma("unroll") for (int bj = 0; bj < 2; ++bj) { if (L0) { _Pragma("unroll") for (int n = 0; n < 2; ++n) xv[(s) & 7][bj][n] = *(const f32x4*)(xf + (size_t)EO_ROW(s) * DM + col0 + bj * HALF + n * 4); } \
            else xw[(s) & 7][bj] = *(const u32x4*)(xb + (size_t)EO_ROW(s) * DM + col0 + bj * HALF); } } while (0)
#pragma unroll
        for (int st = 0; st < EO_D; ++st) EO_LOAD(st);
#pragma unroll
        for (int st = 0; st < 8; ++st) {
            if (st + EO_D < 8) EO_LOAD(st + EO_D);
#if DEV_CODE
            asm volatile("" ::: "memory");
#endif
            const int ai = st >> 2, m = st & 3;
#pragma unroll
            for (int bj = 0; bj < 2; ++bj) { f32x4 x0, x1;
                if (L0) { x0 = xv[st][bj][0]; x1 = xv[st][bj][1]; }
                else { const u32x4 w = xw[st][bj]; x0 = (f32x4){u2f(w.x << 16), u2f(w.x & 0xffff0000u), u2f(w.y << 16), u2f(w.y & 0xffff0000u)}; x1 = (f32x4){u2f(w.z << 16), u2f(w.z & 0xffff0000u), u2f(w.w << 16), u2f(w.w & 0xffff0000u)}; }
                const f32x4 v0 = x0 + gv[bj][0] * acc[ai][bj][m][0], v1 = x1 + gv[bj][1] * acc[ai][bj][m][1];
                u32x4 o; o.x = pack_bf16(v0[0], v0[1]); o.y = pack_bf16(v0[2], v0[3]); o.z = pack_bf16(v1[0], v1[1]); o.w = pack_bf16(v1[2], v1[3]);
                *(u32x4*)(xb + (size_t)EO_ROW(st) * DM + col0 + bj * HALF) = o; }
        }
#undef EO_ROW
#undef EO_LOAD
    }
    HD void operator()(const f32x4 (&acc)[2][2][4][2], const Unit& u, int wr, int wc, int fr, int fq) const {
        if (xin_p) run<true>(acc, u, wr, wc, fr, fq); else run<false>(acc, u, wr, wc, fr, fq);
    }
};
#endif
struct EpiQ {
    static constexpr bool PERM = true;
    bf16_t* O; const float* bias; const float* rs; const float* cs;
    HD void operator()(const f32x4 (&acc)[2][2][4][2], const Unit& u, int wr, int wc, int fr, int fq) const {
        typedef int i32x4_ __attribute__((ext_vector_type(4)));
        const int row0 = u.pm * BM + wr * 64 + fr; const int col0 = u.pn * BM + wc * 32 + 8 * fq;
#pragma unroll
        for (int bj = 0; bj < 2; ++bj) {
            const f32x4 b0 = *(const f32x4*)(bias + col0 + bj * HALF), b1 = *(const f32x4*)(bias + col0 + bj * HALF + 4);
            f32x4 c0 = {1.f, 1.f, 1.f, 1.f}, c1 = {1.f, 1.f, 1.f, 1.f}; if (cs) { c0 = *(const f32x4*)(cs + col0 + bj * HALF); c1 = *(const f32x4*)(cs + col0 + bj * HALF + 4); }
#pragma unroll
            for (int ai = 0; ai < 2; ++ai)
#pragma unroll
                for (int m = 0; m < 4; ++m) { const int row = row0 + ai * HALF + m * 16; f32x4 v0, v1;
                    if (cs) { const float r = rs[row]; v0 = __builtin_convertvector(__builtin_bit_cast(i32x4_, acc[ai][bj][m][0]), f32x4) * (c0 * r) + b0; v1 = __builtin_convertvector(__builtin_bit_cast(i32x4_, acc[ai][bj][m][1]), f32x4) * (c1 * r) + b1; }
                    else { v0 = acc[ai][bj][m][0] + b0; v1 = acc[ai][bj][m][1] + b1; }
                    u32x4 w; w.x = pack_bf16(v0[0], v0[1]); w.y = pack_bf16(v0[2], v0[3]); w.z = pack_bf16(v1[0], v1[1]); w.w = pack_bf16(v1[2], v1[3]);
                    *(u32x4*)(O + (size_t)row * 2048 + col0 + bj * HALF) = w; }
        }
    }
};

#if DEV_CODE || !defined(HOST_TEST)
typedef int i32x4 __attribute__((ext_vector_type(4)));
template <class Epi, class Sched, bool I8 = false>
__device__ __forceinline__ void gemm_phase(PG8_LAS unsigned char* lds, const Gemm g, const Sched& S, const Epi& E, const int tid) {
    const int wid = __builtin_amdgcn_readfirstlane(tid >> 6), lane = tid & 63, wr = wid >> 2, wc = wid & 3, fr = lane & 15, fq = lane >> 4;
    const int K = g.K, nt = K / BK, lda = g.lda;
    unsigned voffA[2], voffB[2];
#pragma unroll
    for (int i = 0; i < 2; ++i) { int R, C; stage_rc(tid * 16 + i * 8192, R, C); const int Rb = Epi::PERM ? ((R & ~31) + perm32(R & 31)) : R;
        voffA[i] = (unsigned)(R * lda + C) * 2u; voffB[i] = (unsigned)(Rb * K + C) * 2u; }
    const size_t kstep = (size_t)(BK * 2);
    const size_t hstepA = (size_t)HALF * lda * 2, tstepA = 2 * hstepA;
    const size_t hstepB = (size_t)HALF * K * 2, tstepB = 2 * hstepB;
    const unsigned ldsw = (unsigned)wid * 1024u;
    const int aoff = lds_byte(wr * 64 + fr, fq * 8), boff = lds_byte(wc * 32 + fr, fq * 8);
#define PG8_SA(b, h) (((b) * 2 + (h)) * HTB)
#define PG8_SB(b, h) ((4 + (b) * 2 + (h)) * HTB)
#define PG8_STAGE(bufoff, gbase, voff) do { _Pragma("unroll") for (int _i = 0; _i < 2; ++_i) \
        __builtin_amdgcn_global_load_lds((const unsigned*)((const char*)(gbase) + (voff)[_i]), (PG8_LAS unsigned*)(lds + (bufoff) + ldsw + _i * 8192), 16, 0, 0); } while (0)
#define PG8_LDA(dst, b, h) do { _Pragma("unroll") for (int m = 0; m < 4; ++m) _Pragma("unroll") for (int k = 0; k < 2; ++k) dst[m][k] = *(const PG8_LAS bf16x8*)(lds + PG8_SA(b, h) + aoff + m * 2048 + k * 1024); } while (0)
#define PG8_LDB(dst, b, h) do { _Pragma("unroll") for (int n = 0; n < 2; ++n) _Pragma("unroll") for (int k = 0; k < 2; ++k) dst[n][k] = *(const PG8_LAS bf16x8*)(lds + PG8_SB(b, h) + boff + n * 2048 + k * 1024); } while (0)
#define PG8_MMA(ai, bj, At, Bt) do { __builtin_amdgcn_s_setprio(1); _Pragma("unroll") for (int m = 0; m < 4; ++m) _Pragma("unroll") for (int n = 0; n < 2; ++n) _Pragma("unroll") for (int k = 0; k < 2; ++k) \
        { if constexpr (I8) acc[ai][bj][m][n] = __builtin_bit_cast(f32x4, __builtin_amdgcn_mfma_i32_16x16x64_i8(__builtin_bit_cast(i32x4, Bt[n][k]), __builtin_bit_cast(i32x4, At[m][k]), __builtin_bit_cast(i32x4, acc[ai][bj][m][n]), 0, 0, 0)); \
          else acc[ai][bj][m][n] = __builtin_amdgcn_mfma_f32_16x16x32_bf16(Bt[n][k], At[m][k], acc[ai][bj][m][n], 0, 0, 0); } __builtin_amdgcn_s_setprio(0); } while (0)
#define PG8_WAIT_V(n) asm volatile("s_waitcnt vmcnt(" #n ")" ::: "memory")
#define PG8_WAIT_L(n) asm volatile("s_waitcnt lgkmcnt(" #n ")" ::: "memory")
#define PG8_BAR __builtin_amdgcn_s_barrier()
#define PG8_SCHED __builtin_amdgcn_sched_barrier(0)
    Unit cur, nxt; int ui = 0;
    if (!S.next(0, cur)) return;
    f32x4 acc[2][2][4][2];
#pragma unroll
    for (int a = 0; a < 2; ++a)
#pragma unroll
        for (int b = 0; b < 2; ++b)
#pragma unroll
            for (int m = 0; m < 4; ++m)
#pragma unroll
                for (int n = 0; n < 2; ++n) acc[a][b][m][n] = (f32x4){0.f, 0.f, 0.f, 0.f};
    bf16x8 At[4][2], B0[2][2], B1[2][2];
    const char* cA = (const char*)g.A + (size_t)cur.pm * tstepA + S.a_off(cur); const char* cB = (const char*)g.Bt + (size_t)cur.pn * tstepB;
    PG8_STAGE(PG8_SB(0, 0), cB, voffB); PG8_STAGE(PG8_SB(0, 1), cB + hstepB, voffB); PG8_STAGE(PG8_SA(0, 0), cA, voffA); PG8_STAGE(PG8_SA(0, 1), cA + hstepA, voffA);
    if (wr == 1) PG8_BAR;
    PG8_WAIT_V(2); PG8_BAR;
    PG8_STAGE(PG8_SB(1, 0), cB + kstep, voffB); PG8_STAGE(PG8_SA(1, 0), cA + kstep, voffA); PG8_STAGE(PG8_SB(1, 1), cB + hstepB + kstep, voffB);
    PG8_WAIT_V(6); PG8_BAR;
    for (;;) {
        const bool has_next = S.next(ui + 1, nxt);
        const char* nA = has_next ? (const char*)g.A + (size_t)nxt.pm * tstepA + S.a_off(nxt) : cA; const char* nB = has_next ? (const char*)g.Bt + (size_t)nxt.pn * tstepB : cB;
#pragma nounroll
        for (int t = 0; t < nt; t += 2) {
            const bool last = (t == nt - 2);
            const char* a1 = cA + (size_t)(t + 1) * kstep;
            const char* a2 = last ? nA : cA + (size_t)(t + 2) * kstep; const char* b2 = last ? nB : cB + (size_t)(t + 2) * kstep;
            const char* a3 = a2 + kstep; const char* b3 = b2 + kstep;
            PG8_LDB(B0, 0, 0); PG8_LDB(B1, 0, 1); PG8_SCHED; PG8_LDA(At, 0, 0); PG8_STAGE(PG8_SA(1, 1), a1 + hstepA, voffA);
            PG8_WAIT_V(8); PG8_WAIT_L(0); PG8_BAR; PG8_MMA(0, 0, At, B0); PG8_MMA(0, 1, At, B1); PG8_BAR; PG8_SCHED;
            PG8_LDA(At, 0, 1); PG8_STAGE(PG8_SB(0, 0), b2, voffB); PG8_STAGE(PG8_SB(0, 1), b2 + hstepB, voffB); PG8_STAGE(PG8_SA(0, 0), a2, voffA);
            PG8_WAIT_V(8); PG8_WAIT_L(0); PG8_BAR; PG8_MMA(1, 0, At, B0); PG8_MMA(1, 1, At, B1); PG8_BAR; PG8_SCHED;
            PG8_LDB(B0, 1, 0); PG8_LDB(B1, 1, 1); PG8_SCHED; PG8_LDA(At, 1, 0); PG8_STAGE(PG8_SA(0, 1), a2 + hstepA, voffA);
            PG8_WAIT_V(8); PG8_WAIT_L(0); PG8_BAR; PG8_MMA(0, 0, At, B0); PG8_MMA(0, 1, At, B1); PG8_BAR; PG8_SCHED;
            PG8_LDA(At, 1, 1); PG8_STAGE(PG8_SB(1, 0), b3, voffB); PG8_STAGE(PG8_SB(1, 1), b3 + hstepB, voffB); PG8_STAGE(PG8_SA(1, 0), a3, voffA);
            PG8_WAIT_V(8); PG8_WAIT_L(0); PG8_BAR; PG8_MMA(1, 0, At, B0); PG8_MMA(1, 1, At, B1); PG8_BAR; PG8_SCHED;
        }
        if (wr == 0) PG8_BAR;
        E(acc, cur, wr, wc, fr, fq);
        if (!has_next) break;
#pragma unroll
        for (int a = 0; a < 2; ++a)
#pragma unroll
            for (int b = 0; b < 2; ++b)
#pragma unroll
                for (int m = 0; m < 4; ++m)
#pragma unroll
                    for (int n = 0; n < 2; ++n) acc[a][b][m][n] = (f32x4){0.f, 0.f, 0.f, 0.f};
        cur = nxt; cA = nA; cB = nB; ++ui;
        if (wr == 1) PG8_BAR;
    }
    PG8_WAIT_V(0);
    PG8_BAR;
#undef PG8_SA
#undef PG8_SB
#undef PG8_STAGE
#undef PG8_LDA
#undef PG8_LDB
#undef PG8_MMA
#undef PG8_WAIT_V
#undef PG8_WAIT_L
#undef PG8_BAR
#undef PG8_SCHED
}
#endif
}

#define XB_TMO      128
#define XB_XCNT(j)  (256  + 64 * (j))
#define XB_XSUB(j)  (1280 + 64 * (j))
#define XB_XGEN(j)  (2304 + 64 * (j))
#define XB_TOP      3328
#define XB_TOPGEN   3392
#define XCD_BAR_WORDS 3456
#define XB_SPIN_CAP (1u << 24)
#define LAS __attribute__((address_space(3)))
#if DEV_CODE || !defined(HOST_TEST)
__device__ __forceinline__ unsigned xb_ld(unsigned* p)              { return __hip_atomic_load(p, __ATOMIC_RELAXED, __HIP_MEMORY_SCOPE_AGENT); }
__device__ __forceinline__ unsigned xb_add(unsigned* p, unsigned v) { return __hip_atomic_fetch_add(p, v, __ATOMIC_RELAXED, __HIP_MEMORY_SCOPE_AGENT); }
__device__ __forceinline__ unsigned xb_xcc_id() { return (unsigned)__builtin_amdgcn_s_getreg((3 << 11) | 20) & 0xFu; }
#define XB_SPIN(cond, bar) do { unsigned _sp = 0; while (cond) { __builtin_amdgcn_s_sleep(1); \
    if ((++_sp & 255u) == 0u) { if (xb_ld(&(bar)[XB_TMO])) break; if (_sp > XB_SPIN_CAP) { atomicAdd(&(bar)[XB_TMO], 1u); break; } } } } while (0)
struct XcdBarrier { unsigned* bar; unsigned x; volatile LAS unsigned* st; };
__device__ __forceinline__ XcdBarrier xcd_barrier_post(unsigned* bar, volatile LAS unsigned* st) {
    XcdBarrier b; b.bar = bar; b.x = xb_xcc_id(); b.st = st;
    if (threadIdx.x == 0) (void)xb_add(&bar[XB_XCNT(b.x)], 1u);
    return b;
}
__device__ __forceinline__ void xcd_barrier_complete(unsigned* bar, unsigned x, unsigned& nloc, unsigned& nx) {
    const unsigned G = gridDim.x * gridDim.y * gridDim.z;
    unsigned sum, cnt, mine, sp = 0u;
    for (;;) {
        sum = 0u; cnt = 0u; mine = 0u;
#pragma unroll
        for (unsigned j = 0; j < 16; ++j) { const unsigned c = xb_ld(&bar[XB_XCNT(j)]); sum += c; cnt += (c > 0u) ? 1u : 0u; mine = (j == x) ? c : mine; }
        if (sum == G) break;
        __builtin_amdgcn_s_sleep(1);
        if ((++sp & 255u) == 0u) { if (xb_ld(&bar[XB_TMO])) break; if (sp > XB_SPIN_CAP) { atomicAdd(&bar[XB_TMO], 1u); break; } }
    }
    nloc = mine > 0u ? mine : 1u; nx = cnt > 0u ? cnt : 1u;
}
template <bool FIRST>
__device__ __forceinline__ void xcd_barrier(const XcdBarrier& b) {
    asm volatile("s_waitcnt vmcnt(0)" ::: "memory");
    __syncthreads();
    if (threadIdx.x == 0) {
        unsigned* bar = b.bar;
        __builtin_amdgcn_s_waitcnt(0);
        unsigned nloc = b.st[0], nx = b.st[1];
        if constexpr (FIRST) { if (nloc == 0u) { xcd_barrier_complete(bar, b.x, nloc, nx); b.st[0] = nloc; b.st[1] = nx; } }
        else { nloc = nloc ? nloc : 1u; nx = nx ? nx : 1u; }
        const unsigned old = xb_add(&bar[XB_XSUB(b.x)], 1u);
        const unsigned gen = old / nloc;
        if (old + 1u == (gen + 1u) * nloc) {
            __builtin_amdgcn_fence(__ATOMIC_RELEASE, "agent");
            asm volatile("s_waitcnt vmcnt(0)" ::: "memory");
            const unsigned og = xb_add(&bar[XB_TOP], 1u);
            const unsigned tg = og / nx;
            if (og + 1u == (tg + 1u) * nx) xb_add(&bar[XB_TOPGEN], 1u);
            else XB_SPIN(xb_ld(&bar[XB_TOPGEN]) == tg, bar);
            __builtin_amdgcn_fence(__ATOMIC_ACQUIRE, "agent");
            xb_add(&bar[XB_XGEN(b.x)], 1u);
            asm volatile("s_waitcnt vmcnt(0)" ::: "memory");
        } else {
            XB_SPIN(xb_ld(&bar[XB_XGEN(b.x)]) == gen, bar);
            __builtin_amdgcn_fence(__ATOMIC_ACQUIRE, "agent");
            asm volatile("s_waitcnt vmcnt(0)" ::: "memory");
        }
    }
    __syncthreads();
}
#endif


#if DEV_CODE || !defined(HOST_TEST)
#define DPP_ADD(v, ctrl) ((v) + __builtin_bit_cast(float, __builtin_amdgcn_update_dpp(0, __builtin_bit_cast(int, (v)), (ctrl), 0xf, 0xf, true)))
__device__ __forceinline__ float row_sum16(float v) { v = DPP_ADD(v, 0xB1); v = DPP_ADD(v, 0x4E); v = DPP_ADD(v, 0x141); v = DPP_ADD(v, 0x140); return v; }
__device__ __forceinline__ float wave_sum(float v) {
    v = row_sum16(v); const int b = __builtin_bit_cast(int, v);
    return (__builtin_bit_cast(float, __builtin_amdgcn_readlane(b, 0)) + __builtin_bit_cast(float, __builtin_amdgcn_readlane(b, 16))) + (__builtin_bit_cast(float, __builtin_amdgcn_readlane(b, 32)) + __builtin_bit_cast(float, __builtin_amdgcn_readlane(b, 48)));
}
#define DPP_MAXNN(v, ctrl) fmaxf((v), __builtin_bit_cast(float, __builtin_amdgcn_update_dpp(0, __builtin_bit_cast(int, (v)), (ctrl), 0xf, 0xf, true)))
__device__ __forceinline__ float wave_max_nn(float v) {
    v = DPP_MAXNN(v, 0xB1); v = DPP_MAXNN(v, 0x4E); v = DPP_MAXNN(v, 0x141); v = DPP_MAXNN(v, 0x140); const int b = __builtin_bit_cast(int, v);
    return fmaxf(fmaxf(__builtin_bit_cast(float, __builtin_amdgcn_readlane(b, 0)), __builtin_bit_cast(float, __builtin_amdgcn_readlane(b, 16))), fmaxf(__builtin_bit_cast(float, __builtin_amdgcn_readlane(b, 32)), __builtin_bit_cast(float, __builtin_amdgcn_readlane(b, 48))));
}
#define DPP_ADDI(v, ctrl) ((v) + __builtin_amdgcn_update_dpp(0, (v), (ctrl), 0xf, 0xf, true))
__device__ __forceinline__ int wave_sum_i32(int v) {
    v = DPP_ADDI(v, 0xB1); v = DPP_ADDI(v, 0x4E); v = DPP_ADDI(v, 0x141); v = DPP_ADDI(v, 0x140);
    return (__builtin_amdgcn_readlane(v, 0) + __builtin_amdgcn_readlane(v, 16)) + (__builtin_amdgcn_readlane(v, 32) + __builtin_amdgcn_readlane(v, 48));
}
__device__ __forceinline__ void unpack8(const u32x4 w, float* f) {
    f[0] = u2f(w.x << 16); f[1] = u2f(w.x & 0xffff0000u); f[2] = u2f(w.y << 16); f[3] = u2f(w.y & 0xffff0000u);
    f[4] = u2f(w.z << 16); f[5] = u2f(w.z & 0xffff0000u); f[6] = u2f(w.w << 16); f[7] = u2f(w.w & 0xffff0000u);
}
__device__ __forceinline__ void dev_norm(const Params& P, int ck, int l, int which, int tid) {
    constexpr int NB = 4;
    const int wave = tid >> 6, lane = tid & 63; const int T = P.cfg.ck_nseq[ck] * P.cfg.ck_L[ck];
    const float* nw = P.in[which ? IN_NORM2_W : IN_NORM1_W] + l * DM;
    for (int g = blockIdx.x * 8 + wave; g < T / NB; g += gridDim.x * 8) {
        const int tl0 = g * NB; const int s = P.cfg.ck_seq0[ck] + tl0 / P.cfg.ck_L[ck];
        const float* ad = ada_row(P, l, s) + (which ? 3072 : 0);
        f32x4 xv[NB][4]; float r[NB], hmax[NB];
#pragma unroll
        for (int b = 0; b < NB; ++b) { const int tok = P.cfg.ck_tok0[ck] + tl0 + b;
            if (which == 0) { const float* x = x_row_in(P, tok);
#pragma unroll
                for (int i = 0; i < 4; ++i) xv[b][i] = *(const f32x4*)(x + lane * 4 + 256 * i); }
            else { const bf16_t* x = P.XB + (size_t)(tl0 + b) * DM;
#pragma unroll
                for (int i = 0; i < 4; ++i) { const u32x2 w = *(const u32x2*)(x + lane * 4 + 256 * i); xv[b][i] = (f32x4){u2f(w.x << 16), u2f(w.x & 0xffff0000u), u2f(w.y << 16), u2f(w.y & 0xffff0000u)}; } } }
#pragma unroll
        for (int b = 0; b < NB; ++b) { float ss = 0.f;
#pragma unroll
            for (int i = 0; i < 4; ++i) ss += xv[b][i][0] * xv[b][i][0] + xv[b][i][1] * xv[b][i][1] + xv[b][i][2] * xv[b][i][2] + xv[b][i][3] * xv[b][i][3];
            ss = wave_sum(ss); r[b] = 1.0f / sqrtf(ss * (1.0f / DM) + 1e-6f); hmax[b] = 0.f; }
#pragma unroll
        for (int i = 0; i < 4; ++i) { const int k = lane * 4 + 256 * i;
            const f32x4 w = *(const f32x4*)(nw + k), sc = *(const f32x4*)(ad + 1024 + k), sh = *(const f32x4*)(ad + k);
#pragma unroll
            for (int b = 0; b < NB; ++b) { const f32x4 hv = xv[b][i] * r[b] * w * (1.0f + sc) + sh; xv[b][i] = hv;
                u32x2 o; o.x = pack_bf16(hv[0], hv[1]); o.y = pack_bf16(hv[2], hv[3]);
                *(u32x2*)(P.H + (size_t)(tl0 + b) * DM + k) = o;
                hmax[b] = fmaxf(hmax[b], fmaxf(fmaxf(fabsf(hv[0]), fabsf(hv[1])), fmaxf(fabsf(hv[2]), fabsf(hv[3])))); } }
#pragma unroll
        for (int b = 0; b < NB; ++b) { float hm = hmax[b];
            hm = wave_max_nn(hm);
            const float hinv = hm > 0.f ? 127.0f / hm : 0.f;
#pragma unroll
            for (int i = 0; i < 4; ++i) { const f32x4 hv = xv[b][i]; const unsigned q = ((unsigned)(int)rintf(hv[0] * hinv) & 0xffu) | (((unsigned)(int)rintf(hv[1] * hinv) & 0xffu) << 8) | (((unsigned)(int)rintf(hv[2] * hinv) & 0xffu) << 16) | (((unsigned)(int)rintf(hv[3] * hinv) & 0xffu) << 24);
                *(unsigned*)(P.HQ + (size_t)(tl0 + b) * DM + lane * 4 + 256 * i) = q; }
            if (lane == 0) P.HS[tl0 + b] = hm * (1.0f / 127.0f); }
    }
}
__device__ __forceinline__ void dev_dt(const Params& P, int ck, int l, int tid) {
    const int wave = tid >> 6, lane = tid & 63, lq = lane & 15, q4 = lane >> 4; const int T = P.cfg.ck_nseq[ck] * P.cfg.ck_L[ck];
    const bf16_t* wa = P.WDT + ((size_t)l * 16 + lq) * DM + 8 * q4;
    const int kh = wave & 1;
    for (int u = blockIdx.x * 4 + (wave >> 1); u < T / 16; u += gridDim.x * 4) {
        const bf16_t* hb = P.H + ((size_t)u * 16 + lq) * DM + 8 * q4 + kh * 512; const bf16_t* wk = wa + kh * 512; f32x4 acc = {0.f, 0.f, 0.f, 0.f};
#pragma unroll
        for (int ks = 0; ks < 16; ++ks) acc = __builtin_amdgcn_mfma_f32_16x16x32_bf16(*(const bf16x8*)(wk + ks * 32), *(const bf16x8*)(hb + ks * 32), acc, 0, 0, 0);
        if (q4 < 2) *(f32x4*)((kh ? P.DT2 : P.DT) + ((size_t)u * 16 + lq) * 8 + 4 * q4) = acc;
    }
}

__device__ __forceinline__ void dev_quant_wrows(const Params& P, int tid) {
    const int wave = tid >> 6, lane = tid & 63; const int per_layer = 4096 + 2048; const int nrow = P.cfg.depth * per_layer;
    for (int r2 = blockIdx.x * 8 + wave; r2 < nrow; r2 += gridDim.x * 8) {
        const int l = r2 / per_layer, r = r2 % per_layer; const bool isq = r >= 4096; const int rr = isq ? r - 4096 : r;
        const bf16_t* src = isq ? P.wq_t + ((size_t)l * 2048 + rr) * DM : P.wcat_t + ((size_t)l * NCAT + NPROJ + rr) * DM;
        float x[16]; unpack8(*(const u32x4*)(src + lane * 16), x); unpack8(*(const u32x4*)(src + lane * 16 + 8), x + 8);
        float amax = 0.f;
#pragma unroll
        for (int i = 0; i < 16; ++i) amax = fmaxf(amax, fabsf(x[i]));
        amax = wave_max_nn(amax);
        const float sc = amax > 0.f ? amax * (1.0f / 127.0f) : 1.0f, inv = 1.0f / sc; u32x4 w;
#pragma unroll
        for (int i = 0; i < 4; ++i) w[i] = ((unsigned)(int)rintf(x[4 * i] * inv) & 0xffu) | (((unsigned)(int)rintf(x[4 * i + 1] * inv) & 0xffu) << 8) | (((unsigned)(int)rintf(x[4 * i + 2] * inv) & 0xffu) << 16) | (((unsigned)(int)rintf(x[4 * i + 3] * inv) & 0xffu) << 24);
        signed char* dst = isq ? P.WQ8 + ((size_t)l * 2048 + rr) * DM : P.WG8 + ((size_t)l * 4096 + rr) * DM;
        *(u32x4*)(dst + lane * 16) = w;
        if (lane == 0) (isq ? P.WQS + (size_t)l * 2048 : P.WGS + (size_t)l * 4096)[rr] = sc;
    }
}
__device__ __forceinline__ void dev_quant_uv(const Params& P, int tid) {
    constexpr int RB = 2;
    const int wave = tid >> 6, lane = tid & 63; const long nrow = (long)P.cfg.depth * 16384;
    for (long g = (long)blockIdx.x * 8 + wave; g < 2 * nrow / RB; g += (long)gridDim.x * 8) {
        f32x4 x[RB][4];
#pragma unroll
        for (int b = 0; b < RB; ++b) { const long r2 = g * RB + b; const bool isv = r2 >= nrow; const long r = isv ? r2 - nrow : r2; const float* src = P.in[isv ? IN_PEER_V : IN_PEER_U] + r * DM + lane * 16;
#pragma unroll
            for (int i = 0; i < 4; ++i) x[b][i] = *(const f32x4*)(src + 4 * i); }
#pragma unroll
        for (int b = 0; b < RB; ++b) { const long r2 = g * RB + b; const bool isv = r2 >= nrow; const long r = isv ? r2 - nrow : r2; float amax = 0.f;
#pragma unroll
            for (int i = 0; i < 4; ++i) amax = fmaxf(amax, fmaxf(fmaxf(fabsf(x[b][i][0]), fabsf(x[b][i][1])), fmaxf(fabsf(x[b][i][2]), fabsf(x[b][i][3]))));
            amax = wave_max_nn(amax);
            const float sc = amax > 0.f ? amax * (1.0f / 127.0f) : 1.0f, inv = 1.0f / sc;
            u32x4 w;
#pragma unroll
            for (int i = 0; i < 4; ++i) { const unsigned b0 = (unsigned)(int)rintf(x[b][i][0] * inv) & 0xffu, b1 = (unsigned)(int)rintf(x[b][i][1] * inv) & 0xffu, b2 = (unsigned)(int)rintf(x[b][i][2] * inv) & 0xffu, b3 = (unsigned)(int)rintf(x[b][i][3] * inv) & 0xffu;
                w[i] = b0 | (b1 << 8) | (b2 << 16) | (b3 << 24); }
            *(u32x4*)(P.PU + r * 2048 + (isv ? 1024 : 0) + lane * 16) = w;
            if (lane == 0) (isv ? P.PVs : P.PUs)[r] = sc; }
    }
}
__device__ __forceinline__ void ub16_to_f(const u32x4 w, float* f) {
#pragma unroll
    for (int i = 0; i < 4; ++i) { f[4 * i] = (float)(w[i] & 0xffu); f[4 * i + 1] = (float)((w[i] >> 8) & 0xffu); f[4 * i + 2] = (float)((w[i] >> 16) & 0xffu); f[4 * i + 3] = (float)(w[i] >> 24); }
}
#define PEER_IX4(IX, q) do { const int q_ = (q) < 32 ? (q) : 31; const int mi_ = (q_ >> 4) ? my_i1 : my_i0; \
        _Pragma("unroll") for (int j = 0; j < 4; ++j) IX[j] = __builtin_amdgcn_readlane(mi_, (q_ & 15) * 4 + j); } while (0)
#define PEER_LOAD4(B, base, IX) do { _Pragma("unroll") for (int j = 0; j < 4; ++j) B[j] = *(const u32x4*)((base) + (size_t)IX[j] * 2048); } while (0)
#define PEER_DOT4(B, q) do { _Pragma("unroll") for (int j = 0; j < 4; ++j) { int t = __builtin_amdgcn_sdot4((int)hq.x, (int)B[j].x, 0, false); t = __builtin_amdgcn_sdot4((int)hq.y, (int)B[j].y, t, false); \
            t = __builtin_amdgcn_sdot4((int)hq.z, (int)B[j].z, t, false); t = __builtin_amdgcn_sdot4((int)hq.w, (int)B[j].w, t, false); \
            const int dsum = wave_sum_i32(t); const bool mine_ = lane == (((q) & 15) * 4 + j); \
            if ((q) >> 4) dl1 = mine_ ? dsum : dl1; else dl0 = mine_ ? dsum : dl0; } } while (0)
#define PEER_ACC4(B, q) do { const int c4_ = __builtin_amdgcn_readlane(((q) >> 4) ? pk1 : pk0, (q) & 15); \
        _Pragma("unroll") for (int k = 0; k < 4; ++k) { \
            const unsigned t0 = __builtin_amdgcn_perm(B[1][k], B[0][k], 0x05010400u), t1 = __builtin_amdgcn_perm(B[1][k], B[0][k], 0x07030602u), t2 = __builtin_amdgcn_perm(B[3][k], B[2][k], 0x05010400u), t3 = __builtin_amdgcn_perm(B[3][k], B[2][k], 0x07030602u); \
            acci[4 * k + 0] = __builtin_amdgcn_sdot4((int)__builtin_amdgcn_perm(t2, t0, 0x05040100u), c4_, acci[4 * k + 0], false); acci[4 * k + 1] = __builtin_amdgcn_sdot4((int)__builtin_amdgcn_perm(t2, t0, 0x07060302u), c4_, acci[4 * k + 1], false); \
            acci[4 * k + 2] = __builtin_amdgcn_sdot4((int)__builtin_amdgcn_perm(t3, t1, 0x05040100u), c4_, acci[4 * k + 2], false); acci[4 * k + 3] = __builtin_amdgcn_sdot4((int)__builtin_amdgcn_perm(t3, t1, 0x07060302u), c4_, acci[4 * k + 3], false); } } while (0)
__device__ __forceinline__ void dev_peer(const Params& P, int ck, int l, int tid, bool dry = false) {
    const int wave = tid >> 6, lane = tid & 63; const int T = P.cfg.ck_nseq[ck] * P.cfg.ck_L[ck];
    const unsigned char* PUl = P.PU + (size_t)l * 16384 * 2048 + lane * 16; const unsigned char* PVl = PUl + 1024;
    const float* su = P.PUs + (size_t)l * 16384; const float* sv = P.PVs + (size_t)l * 16384;
    for (int tl = blockIdx.x * 8 + wave; tl < T; tl += gridDim.x * 8) {
        float acc[16]; float cs = 0.f;
        const int my_i0 = P.PIDX[(size_t)tl * 128 + lane], my_i1 = P.PIDX[(size_t)tl * 128 + 64 + lane];
        const u32x4 hq = *(const u32x4*)(P.HQ + (size_t)tl * DM + lane * 16); const float hsc = P.HS[tl];
#pragma unroll
        for (int i = 0; i < 16; ++i) acc[i] = 0.f;
        const float my_g0 = P.PG[(size_t)tl * 128 + lane] * sv[my_i0], my_g1 = P.PG[(size_t)tl * 128 + 64 + lane] * sv[my_i1], my_s0 = su[my_i0] * hsc, my_s1 = su[my_i1] * hsc;
        asm volatile("" :: "v"(my_i0), "v"(my_i1), "v"(my_g0), "v"(my_g1), "v"(my_s0), "v"(my_s1));
        u32x4 A[4], B[4], C[4], D[4]; int ixa[4], ixb[4], ixc[4], ixd[4]; int dl0 = 0, dl1 = 0;
        PEER_IX4(ixa, 0); PEER_IX4(ixb, 1); PEER_IX4(ixc, 2); PEER_IX4(ixd, 3);
        PEER_LOAD4(A, PUl, ixa); PEER_LOAD4(B, PUl, ixb); PEER_LOAD4(C, PUl, ixc); PEER_LOAD4(D, PUl, ixd);
#pragma unroll 1
        for (int q = 0; q < 28; q += 4) {
            PEER_IX4(ixa, q + 4); PEER_DOT4(A, q); PEER_LOAD4(A, PUl, ixa); __builtin_amdgcn_sched_barrier(0);
            PEER_IX4(ixb, q + 5); PEER_DOT4(B, q + 1); PEER_LOAD4(B, PUl, ixb); __builtin_amdgcn_sched_barrier(0);
            PEER_IX4(ixc, q + 6); PEER_DOT4(C, q + 2); PEER_LOAD4(C, PUl, ixc); __builtin_amdgcn_sched_barrier(0);
            PEER_IX4(ixd, q + 7); PEER_DOT4(D, q + 3); PEER_LOAD4(D, PUl, ixd); __builtin_amdgcn_sched_barrier(0);
        }
        PEER_IX4(ixa, 0); PEER_DOT4(A, 28); PEER_LOAD4(A, PVl, ixa); __builtin_amdgcn_sched_barrier(0);
        PEER_IX4(ixb, 1); PEER_DOT4(B, 29); PEER_LOAD4(B, PVl, ixb); __builtin_amdgcn_sched_barrier(0);
        PEER_IX4(ixc, 2); PEER_DOT4(C, 30); PEER_LOAD4(C, PVl, ixc); __builtin_amdgcn_sched_barrier(0);
        PEER_IX4(ixd, 3); PEER_DOT4(D, 31); PEER_LOAD4(D, PVl, ixd); __builtin_amdgcn_sched_barrier(0);
        const float c0 = my_g0 * gelu_as((float)dl0 * my_s0), c1 = my_g1 * gelu_as((float)dl1 * my_s1);
        float cmax = fmaxf(fabsf(c0), fabsf(c1));
        cmax = wave_max_nn(cmax);
        const float cinv = cmax > 0.f ? 127.0f / cmax : 0.f, csc = cmax * (1.0f / 127.0f);
        const int cq0 = (int)rintf(c0 * cinv) & 0xff, cq1 = (int)rintf(c1 * cinv) & 0xff; const int l4 = (lane & 15) * 4;
        const int pk0 = __shfl(cq0, l4) | (__shfl(cq0, l4 + 1) << 8) | (__shfl(cq0, l4 + 2) << 16) | (__shfl(cq0, l4 + 3) << 24);
        const int pk1 = __shfl(cq1, l4) | (__shfl(cq1, l4 + 1) << 8) | (__shfl(cq1, l4 + 2) << 16) | (__shfl(cq1, l4 + 3) << 24);
        int acci[16];
#pragma unroll
        for (int i = 0; i < 16; ++i) acci[i] = 0;
#pragma unroll 1
        for (int q = 0; q < 28; q += 4) {
            PEER_IX4(ixa, q + 4); PEER_ACC4(A, q); PEER_LOAD4(A, PVl, ixa); __builtin_amdgcn_sched_barrier(0);
            PEER_IX4(ixb, q + 5); PEER_ACC4(B, q + 1); PEER_LOAD4(B, PVl, ixb); __builtin_amdgcn_sched_barrier(0);
            PEER_IX4(ixc, q + 6); PEER_ACC4(C, q + 2); PEER_LOAD4(C, PVl, ixc); __builtin_amdgcn_sched_barrier(0);
            PEER_IX4(ixd, q + 7); PEER_ACC4(D, q + 3); PEER_LOAD4(D, PVl, ixd); __builtin_amdgcn_sched_barrier(0);
        }
        PEER_ACC4(A, 28); __builtin_amdgcn_sched_barrier(0); PEER_ACC4(B, 29); __builtin_amdgcn_sched_barrier(0); PEER_ACC4(C, 30); __builtin_amdgcn_sched_barrier(0); PEER_ACC4(D, 31);
        const int tok = P.cfg.ck_tok0[ck] + tl, s = P.cfg.ck_seq0[ck] + tl / P.cfg.ck_L[ck];
#pragma unroll
        for (int i = 0; i < 16; ++i) acc[i] = (float)acci[i] * csc;
        cs = 0.f;
        const float* g2 = ada_row(P, l, s) + 5120 + lane * 16; float* xo = P.out + (size_t)tok * DM + lane * 16; bf16_t* xbr = P.XB + (size_t)tl * DM + lane * 16;
        f32x4 xn[4]; float ss = 0.f; const u32x4 xw0 = *(const u32x4*)xbr, xw1 = *(const u32x4*)(xbr + 8);
        const f32x4 xold[4] = {{u2f(xw0.x << 16), u2f(xw0.x & 0xffff0000u), u2f(xw0.y << 16), u2f(xw0.y & 0xffff0000u)}, {u2f(xw0.z << 16), u2f(xw0.z & 0xffff0000u), u2f(xw0.w << 16), u2f(xw0.w & 0xffff0000u)},
                               {u2f(xw1.x << 16), u2f(xw1.x & 0xffff0000u), u2f(xw1.y << 16), u2f(xw1.y & 0xffff0000u)}, {u2f(xw1.z << 16), u2f(xw1.z & 0xffff0000u), u2f(xw1.w << 16), u2f(xw1.w & 0xffff0000u)}};
#pragma unroll
        for (int q = 0; q < 4; ++q) { const f32x4 a = {acc[q * 4] - cs, acc[q * 4 + 1] - cs, acc[q * 4 + 2] - cs, acc[q * 4 + 3] - cs};
            xn[q] = xold[q] + *(const f32x4*)(g2 + 4 * q) * a; ss += xn[q][0] * xn[q][0] + xn[q][1] * xn[q][1] + xn[q][2] * xn[q][2] + xn[q][3] * xn[q][3]; }
        if (l + 1 < P.cfg.depth) { u32x4 o0, o1;
            o0.x = pack_bf16(xn[0][0], xn[0][1]); o0.y = pack_bf16(xn[0][2], xn[0][3]); o0.z = pack_bf16(xn[1][0], xn[1][1]); o0.w = pack_bf16(xn[1][2], xn[1][3]);
            o1.x = pack_bf16(xn[2][0], xn[2][1]); o1.y = pack_bf16(xn[2][2], xn[2][3]); o1.z = pack_bf16(xn[3][0], xn[3][1]); o1.w = pack_bf16(xn[3][2], xn[3][3]);
            *(u32x4*)xbr = o0; *(u32x4*)(xbr + 8) = o1; }
        else {
#pragma unroll
            for (int q = 0; q < 4; ++q) *(f32x4*)(xo + 4 * q) = xn[q]; }
        if (l + 1 < P.cfg.depth) {
            ss = wave_sum(ss); const float r = 1.0f / sqrtf(ss * (1.0f / DM) + 1e-6f);
            const float* nw = P.in[IN_NORM1_W] + (l + 1) * DM + lane * 16; const float* ad = ada_row(P, l + 1, s) + lane * 16; u32x4 o[2];
            f32x4 hvv[4];
#pragma unroll
            for (int q = 0; q < 4; ++q) { const f32x4 w = *(const f32x4*)(nw + 4 * q), sc = *(const f32x4*)(ad + 1024 + 4 * q), sh = *(const f32x4*)(ad + 4 * q); const f32x4 hv = xn[q] * r * w * (1.0f + sc) + sh; hvv[q] = hv;
                o[q >> 1][(q & 1) * 2] = pack_bf16(hv[0], hv[1]); o[q >> 1][(q & 1) * 2 + 1] = pack_bf16(hv[2], hv[3]); }
            bf16_t* hr = P.H + (size_t)tl * DM + lane * 16; *(u32x4*)hr = o[0]; *(u32x4*)(hr + 8) = o[1];
            float hmax = 0.f;
#pragma unroll
            for (int q = 0; q < 4; ++q) hmax = fmaxf(hmax, fmaxf(fmaxf(fabsf(hvv[q][0]), fabsf(hvv[q][1])), fmaxf(fabsf(hvv[q][2]), fabsf(hvv[q][3]))));
            hmax = wave_max_nn(hmax);
            const float hinv = hmax > 0.f ? 127.0f / hmax : 0.f; u32x4 qw;
#pragma unroll
            for (int q = 0; q < 4; ++q) qw[q] = ((unsigned)(int)rintf(hvv[q][0] * hinv) & 0xffu) | (((unsigned)(int)rintf(hvv[q][1] * hinv) & 0xffu) << 8) | (((unsigned)(int)rintf(hvv[q][2] * hinv) & 0xffu) << 16) | (((unsigned)(int)rintf(hvv[q][3] * hinv) & 0xffu) << 24);
            *(u32x4*)(P.HQ + (size_t)tl * DM + lane * 16) = qw; if (lane == 0) P.HS[tl] = hmax * (1.0f / 127.0f);
        }
    }
}
__device__ __forceinline__ void dev_hyena(const Params& P, int ck, int l, int order, LAS unsigned char* lds, int tid) {
    const int wave = tid >> 6, lane = tid & 63; const int L = P.cfg.ck_L[ck], nseq = P.cfg.ck_nseq[ck], li = P.cfg.ck_li[ck];
    const int XL = 2 * L + 32, ZL = L + 2 * HY_PAD; const int tps = L / 256, ntile = nseq * tps;
    LAS unsigned* R0 = (LAS unsigned*)lds; LAS unsigned* R1 = R0 + XL / 2 + 4; LAS unsigned short* ZP = (LAS unsigned short*)(R1 + XL / 2 + 4);
    for (int c = blockIdx.x; c < 256; c += gridDim.x) {
        __syncthreads();
        { const u32x4* g = (const u32x4*)(P.GT + gt_base(P, l, li, order * 256 + c)); u32x4 gr[3], zr[8];
#pragma unroll
          for (int k = 0; k < 3; ++k) { const int i = tid + k * NTHREADS_; gr[k] = g[i < XL / 8 ? i : 0]; }
#pragma unroll
          for (int sl = 0; sl < 8; ++sl) { const int slc = sl < nseq ? sl : nseq - 1; const bf16_t* z = order == 0 ? P.HYT + ((size_t)slc * 768 + c) * L : P.HYZ + ((size_t)slc * 256 + c) * L;
              zr[sl] = *(const u32x4*)(z + (tid < L / 8 ? tid : 0) * 8); }
#pragma unroll
          for (int k = 0; k < 3; ++k) { const int i = tid + k * NTHREADS_; if (i < XL / 8) ((LAS u32x4*)R0)[i] = gr[k]; }
          if (tid < 4) R0[XL / 2 + tid] = 0u;
#pragma unroll
          for (int sl = 0; sl < 8; ++sl) if (sl < nseq) { LAS unsigned short* zp = ZP + (size_t)sl * ZL;
              if (tid < L / 8) *(LAS u32x4*)(zp + HY_PAD + tid * 8) = zr[sl];
              for (int i = tid; i < HY_PAD / 8; i += NTHREADS_) { *(LAS u32x4*)(zp + i * 8) = (u32x4){0u, 0u, 0u, 0u}; *(LAS u32x4*)(zp + HY_PAD + L + i * 8) = (u32x4){0u, 0u, 0u, 0u}; } } }
        __syncthreads();
        for (int w = tid; w < XL / 2; w += NTHREADS_) R1[w] = (R0[w] >> 16) | (R0[w + 1] << 16);
        __syncthreads();
        const float skip = P.in[IN_HY_BIAS][(l * 2 + order) * 256 + c];
        const int ngrp = nseq / 4;
        for (int f = wave; f < (tps / 2) * ngrp; f += 8) {
            const int ct0 = (f % (tps / 2)) * 2, sg = f / (tps / 2); int m_lo, m_hi; hy_mrange(L, ct0, m_lo, m_hi);
            const LAS unsigned short* zp = ZP + (size_t)(sg * 4) * ZL + HY_PAD;
            f32x4 acc[2][4];
#pragma unroll
            for (int j = 0; j < 4; ++j) { acc[0][j] = (f32x4){0.f, 0.f, 0.f, 0.f}; acc[1][j] = (f32x4){0.f, 0.f, 0.f, 0.f}; }
            u32x2 gwp[2][4];
#pragma unroll
            for (int cc = 0; cc < 2; ++cc)
#pragma unroll
                for (int j = 0; j < 4; ++j) gwp[cc][j] = *(const u32x2*)(P.HYT + ((size_t)(sg * 4 + j) * 768 + (order == 0 ? 256 : 512) + c) * L + 256 * (ct0 + cc) + 16 * (lane & 15) + 4 * (lane >> 4));
            u32x4 na0, na1, nb[4];
#define HY_FRAGS(mm) do { const int x0_ = hy_afrag_x0(L, (mm), lane); const LAS unsigned* ab_ = (x0_ & 1) ? R1 + ((x0_ - 1) >> 1) : R0 + (x0_ >> 1); \
                na0.x = ab_[0]; na0.y = ab_[1]; na0.z = ab_[2]; na0.w = ab_[3]; na1.x = ab_[-128]; na1.y = ab_[-127]; na1.z = ab_[-126]; na1.w = ab_[-125]; \
                const int bp_ = hy_bfrag_pos(ct0, (mm), lane); _Pragma("unroll") for (int j = 0; j < 4; ++j) nb[j] = *(const LAS u32x4*)(zp + (size_t)j * ZL + bp_); } while (0)
            HY_FRAGS(m_lo);
#pragma unroll 2
            for (int m = m_lo; m <= m_hi; ++m) {
                const u32x4 a0 = na0, a1 = na1; u32x4 bq[4];
#pragma unroll
                for (int j = 0; j < 4; ++j) bq[j] = nb[j];
                HY_FRAGS(m < m_hi ? m + 1 : m_hi);
#pragma unroll
                for (int j = 0; j < 4; ++j) { const bf16x8 b = __builtin_bit_cast(bf16x8, bq[j]);
                    acc[0][j] = __builtin_amdgcn_mfma_f32_16x16x32_bf16(__builtin_bit_cast(bf16x8, a0), b, acc[0][j], 0, 0, 0);
                    acc[1][j] = __builtin_amdgcn_mfma_f32_16x16x32_bf16(__builtin_bit_cast(bf16x8, a1), b, acc[1][j], 0, 0, 0); }
            }
#undef HY_FRAGS
#pragma unroll
            for (int cc = 0; cc < 2; ++cc) {
                const int t = 256 * (ct0 + cc) + 16 * (lane & 15) + 4 * (lane >> 4);
#pragma unroll
                for (int j = 0; j < 4; ++j) { const int sl = sg * 4 + j;
                    const u32x2 zw = *(const LAS u32x2*)(zp + (size_t)j * ZL + t); const u32x2 gw = gwp[cc][j];
                    const float o0 = u2f(gw.x << 16) * (acc[cc][j][0] + u2f(zw.x << 16) * skip), o1 = u2f(gw.x & 0xffff0000u) * (acc[cc][j][1] + u2f(zw.x & 0xffff0000u) * skip);
                    const float o2 = u2f(gw.y << 16) * (acc[cc][j][2] + u2f(zw.y << 16) * skip), o3 = u2f(gw.y & 0xffff0000u) * (acc[cc][j][3] + u2f(zw.y & 0xffff0000u) * skip);
                    u32x2 ow; ow.x = pack_bf16(o0, o1); ow.y = pack_bf16(o2, o3);
                    bf16_t* dst = order == 0 ? P.HYZ + ((size_t)sl * 256 + c) * L + t : P.HYT + ((size_t)sl * 768 + c) * L + t;
                    *(u32x2*)dst = ow; }
            }
        }
    }
}
__device__ __forceinline__ void dev_cum(const Params& P, int ck, int l, int tid) {
    const int wave = tid >> 6, lane = tid & 63; const int L = P.cfg.ck_L[ck], nchunk = L / SCK, nseq = P.cfg.ck_nseq[ck]; const int nunit = 2 * 2 * nseq * nchunk * 4;
    for (int u = blockIdx.x * 8 + wave; u < nunit; u += gridDim.x * 8) {
        const int h = u & 3; const int c = (u >> 2) % nchunk; const int sl = ((u >> 2) / nchunk) % nseq; const int d = ((u >> 2) / nchunk / nseq) & 1; const int ty = (u >> 2) / nchunk / nseq / 2;
        const int jj = d ? SCK - 1 - lane : lane; float* cum = P.CUM + cum_idx(P, ty, d, sl, h, c * SCK, L);
        if (ty == 0) { cum[jj] = (float)(lane + 1) * ret_la(d, h); continue; }
        const float A = -expf(P.in[IN_SSM_A_LOG][l * 8 + d * 4 + h]); const float dtb = P.in[IN_SSM_DT_BIAS][l * 8 + d * 4 + h];
        const size_t tl = (size_t)sl * L + c * SCK + jj; const float dt = softplusf(P.DT[tl * 8 + d * 4 + h] + P.DT2[tl * 8 + d * 4 + h] + dtb);
        float v = dt * A;
#pragma unroll
        for (int o = 1; o < 64; o <<= 1) { const float t = __shfl_up(v, o); if (lane >= o) v += t; }
        cum[jj] = v; P.DTS[cum_idx(P, 0, d, sl, h, c * SCK, L) + jj] = dt;
    }
}
template <int TY> __device__ __forceinline__ void dev_scan_state(const Params& P, int ck, int l, int tid) {
    constexpr int N = TY ? 64 : 32, NT = N / 16;
    const int wave = tid >> 6, lane = tid & 63, lq = lane & 15, q4 = lane >> 4; const int L = P.cfg.ck_L[ck], nseq = P.cfg.ck_nseq[ck], nchunk = L / SCK; const int nunit = 2 * nseq * nchunk * 4;
    for (int u = blockIdx.x * 8 + wave; u < nunit; u += gridDim.x * 8) {
        const int h = u & 3, c = (u >> 2) % nchunk, sl = ((u >> 2) / nchunk) % nseq, d = (u >> 2) / nchunk / nseq; const int t0 = c * SCK;
        const float* cum = P.CUM + cum_idx(P, TY, d, sl, h, t0, L); const float* dts = P.DTS + cum_idx(P, 0, d, sl, h, t0, L); const float cref = cum[d ? 0 : SCK - 1];
        f32x4 acc[NT][4];
#pragma unroll
        for (int nt = 0; nt < NT; ++nt)
#pragma unroll
            for (int pt = 0; pt < 4; ++pt) acc[nt][pt] = (f32x4){0.f, 0.f, 0.f, 0.f};
#pragma unroll
        for (int ks = 0; ks < 2; ++ks) { const int j0 = ks * 32 + 8 * q4;
            float w[8]; { const f32x4 c0 = *(const f32x4*)(cum + j0), c1 = *(const f32x4*)(cum + j0 + 4);
#pragma unroll
                for (int jj = 0; jj < 4; ++jj) { w[jj] = fexpf(cref - c0[jj]); w[4 + jj] = fexpf(cref - c1[jj]); }
                if (TY) { const f32x4 d0 = *(const f32x4*)(dts + j0), d1 = *(const f32x4*)(dts + j0 + 4);
#pragma unroll
                    for (int jj = 0; jj < 4; ++jj) { w[jj] *= d0[jj]; w[4 + jj] *= d1[jj]; } }
                else {
#pragma unroll
                    for (int jj = 0; jj < 8; ++jj) w[jj] *= 0.17677669529663687f; } }
            bf16x8 bf[4], af[NT];
#pragma unroll
            for (int pt = 0; pt < 4; ++pt) { float v[8]; unpack8(*(const u32x4*)(sc_vT(P, TY, sl, h, pt * 16 + lq, L) + t0 + j0), v);
                u32x4 pw; pw.x = pack_bf16(v[0] * w[0], v[1] * w[1]); pw.y = pack_bf16(v[2] * w[2], v[3] * w[3]); pw.z = pack_bf16(v[4] * w[4], v[5] * w[5]); pw.w = pack_bf16(v[6] * w[6], v[7] * w[7]);
                bf[pt] = __builtin_bit_cast(bf16x8, pw); }
#pragma unroll
            for (int nt = 0; nt < NT; ++nt) af[nt] = *(const bf16x8*)(sc_kT(P, TY, sl, h, nt * 16 + lq, L) + t0 + j0);
#pragma unroll
            for (int nt = 0; nt < NT; ++nt)
#pragma unroll
                for (int pt = 0; pt < 4; ++pt) acc[nt][pt] = __builtin_amdgcn_mfma_f32_16x16x32_bf16(af[nt], bf[pt], acc[nt][pt], 0, 0, 0);
        }
        float* cs = (TY ? P.CSS : P.CSR) + (size_t)u * (N * 64);
#pragma unroll
        for (int nt = 0; nt < NT; ++nt)
#pragma unroll
            for (int pt = 0; pt < 4; ++pt) *(f32x4*)(cs + (pt * 16 + lq) * N + nt * 16 + 4 * q4) = acc[nt][pt];
    }
}
template <int TY> __device__ __forceinline__ void dev_scan_out(const Params& P, int ck, int l, int tid) {
    constexpr int N = TY ? 64 : 32, NK = N / 32;
    const int wave = tid >> 6, lane = tid & 63, lq = lane & 15, q4 = lane >> 4; const int L = P.cfg.ck_L[ck], nseq = P.cfg.ck_nseq[ck], nchunk = L / SCK;
    for (int wi = blockIdx.x; wi < nseq * nchunk; wi += gridDim.x) {
        const int sl = wi / nchunk, c = wi % nchunk, d = wave >> 2, h = wave & 3; const int u = (int)sc_unit(d, sl, c, h, nseq, nchunk); const int t0 = c * SCK; const size_t tl0 = (size_t)sl * L + t0;
        const float* cum = P.CUM + cum_idx(P, TY, d, sl, h, t0, L); const float* dts = P.DTS + cum_idx(P, 0, d, sl, h, t0, L);
        bf16x8 kf[4][NK], vf[4][2], hf[4][NK]; f32x4 cj[4], vs[4];
#pragma unroll
        for (int jt = 0; jt < 4; ++jt) {
#pragma unroll
            for (int ks = 0; ks < NK; ++ks) kf[jt][ks] = *(const bf16x8*)(sc_krow(P, TY, h, tl0 + jt * 16 + lq) + ks * 32 + 8 * q4);
            cj[jt] = *(const f32x4*)(cum + jt * 16 + 4 * q4);
            if (TY) vs[jt] = *(const f32x4*)(dts + jt * 16 + 4 * q4); else vs[jt] = (f32x4){0.17677669529663687f, 0.17677669529663687f, 0.17677669529663687f, 0.17677669529663687f}; }
        const bf16_t* hb = (TY ? P.HBS : P.HBR) + (size_t)u * (N * 64);
#pragma unroll
        for (int pt = 0; pt < 4; ++pt) { const bf16_t* vp = sc_vT(P, TY, sl, h, pt * 16 + lq, L) + t0 + 4 * q4;
#pragma unroll
            for (int kp = 0; kp < 2; ++kp) { const u32x2 lo = *(const u32x2*)(vp + kp * 32), hi = *(const u32x2*)(vp + kp * 32 + 16); vf[pt][kp] = __builtin_bit_cast(bf16x8, (u32x4){lo.x, lo.y, hi.x, hi.y}); }
#pragma unroll
            for (int ks = 0; ks < NK; ++ks) hf[pt][ks] = *(const bf16x8*)(hb + (pt * 16 + lq) * N + ks * 32 + 8 * q4); }
        bf16_t* Y = (bf16_t*)(TY ? P.SSDY : P.RETY) + (size_t)d * P.cfg.Tmax * 256;
#pragma unroll
        for (int it = 0; it < 4; ++it) {
            bf16x8 qf[NK];
#pragma unroll
            for (int ks = 0; ks < NK; ++ks) qf[ks] = *(const bf16x8*)(sc_qrow(P, TY, h, tl0 + it * 16 + lq) + ks * 32 + 8 * q4);
            const float ci = cum[it * 16 + lq];
            f32x4 y[4];
#pragma unroll
            for (int pt = 0; pt < 4; ++pt) y[pt] = (f32x4){0.f, 0.f, 0.f, 0.f};
#pragma unroll
            for (int kp = 0; kp < 2; ++kp) {
                if (d == 0 ? (2 * kp > it) : (2 * kp + 1 < it)) continue;
                float p[8];
#pragma unroll
                for (int e = 0; e < 2; ++e) { const int jt = 2 * kp + e;
                    f32x4 sacc = {0.f, 0.f, 0.f, 0.f};
#pragma unroll
                    for (int ks = 0; ks < NK; ++ks) sacc = __builtin_amdgcn_mfma_f32_16x16x32_bf16(kf[jt][ks], qf[ks], sacc, 0, 0, 0);
#pragma unroll
                    for (int r = 0; r < 4; ++r) { const int jj = jt * 16 + 4 * q4 + r, ii = it * 16 + lq; const bool keep = d == 0 ? (jj <= ii) : (jj >= ii);
                        p[4 * e + r] = keep ? sacc[r] * fexpf(ci - cj[jt][r]) * vs[jt][r] : 0.f; } }
                u32x4 pw; pw.x = pack_bf16(p[0], p[1]); pw.y = pack_bf16(p[2], p[3]); pw.z = pack_bf16(p[4], p[5]); pw.w = pack_bf16(p[6], p[7]);
                const bf16x8 pb = __builtin_bit_cast(bf16x8, pw);
#pragma unroll
                for (int pt = 0; pt < 4; ++pt) y[pt] = __builtin_amdgcn_mfma_f32_16x16x32_bf16(vf[pt][kp], pb, y[pt], 0, 0, 0);
            }
            { const float eci = fexpf(ci);
#pragma unroll
              for (int ks = 0; ks < NK; ++ks) { float qv[8]; unpack8(__builtin_bit_cast(u32x4, qf[ks]), qv);
                  u32x4 qw; qw.x = pack_bf16(qv[0] * eci, qv[1] * eci); qw.y = pack_bf16(qv[2] * eci, qv[3] * eci); qw.z = pack_bf16(qv[4] * eci, qv[5] * eci); qw.w = pack_bf16(qv[6] * eci, qv[7] * eci);
                  const bf16x8 qs = __builtin_bit_cast(bf16x8, qw);
#pragma unroll
                  for (int pt = 0; pt < 4; ++pt) y[pt] = __builtin_amdgcn_mfma_f32_16x16x32_bf16(hf[pt][ks], qs, y[pt], 0, 0, 0); } }
#pragma unroll
            for (int pt = 0; pt < 4; ++pt) { u32x2 o; o.x = pack_bf16(y[pt][0], y[pt][1]); o.y = pack_bf16(y[pt][2], y[pt][3]); *(u32x2*)(Y + (tl0 + it * 16 + lq) * 256 + h * 64 + pt * 16 + 4 * q4) = o; }
        }
    }
}
__device__ __forceinline__ void dev_scan_post(const Params& P, int ck, int l, int tid) {
    constexpr int NB = 8;
    const int wave = tid >> 6, lane = tid & 63; const int T = P.cfg.ck_nseq[ck] * P.cfg.ck_L[ck]; const int c4 = lane * 4; const size_t dstr = (size_t)P.cfg.Tmax * 256;
    const f32x4 wr = *(const f32x4*)(P.in[IN_RET_GN_W] + l * 256 + c4), ws = *(const f32x4*)(P.in[IN_SSM_NORM_W] + l * 256 + c4); const float Dh = P.in[IN_SSM_D][l * 4 + (lane >> 4)];
    const int L_ = P.cfg.ck_L[ck], nchunk_ = L_ / SCK; (void)T;
    for (int wi = blockIdx.x; wi < P.cfg.ck_nseq[ck] * nchunk_; wi += gridDim.x) {
        const size_t g = ((size_t)(wi / nchunk_) * L_ + (size_t)(wi % nchunk_) * SCK) / NB + wave;
        u32x2 ra[NB], rb[NB], rg[NB], sa[NB], sb[NB], sx[NB], sz[NB];
#pragma unroll
        for (int b = 0; b < NB; ++b) { const size_t tl = (size_t)g * NB + b;
            ra[b] = *(const u32x2*)((const bf16_t*)P.RETY + tl * 256 + c4); rb[b] = *(const u32x2*)((const bf16_t*)P.RETY + dstr + tl * 256 + c4); rg[b] = *(const u32x2*)(P.PROJ + tl * NPROJ + C_RG + c4);
            sa[b] = *(const u32x2*)((const bf16_t*)P.SSDY + tl * 256 + c4); sb[b] = *(const u32x2*)((const bf16_t*)P.SSDY + dstr + tl * 256 + c4); sx[b] = *(const u32x2*)(P.XBC + tl * 512 + c4); sz[b] = *(const u32x2*)(P.PROJ + tl * NPROJ + C_SZ + c4); }
#pragma unroll
        for (int b = 0; b < NB; ++b) { const size_t tl = (size_t)g * NB + b;
            { const u32x2 ya = ra[b], yb = rb[b], gw = rg[b];
              const f32x4 y = {u2f(ya.x << 16) + u2f(yb.x << 16), u2f(ya.x & 0xffff0000u) + u2f(yb.x & 0xffff0000u), u2f(ya.y << 16) + u2f(yb.y << 16), u2f(ya.y & 0xffff0000u) + u2f(yb.y & 0xffff0000u)};
              float ss = row_sum16(y[0] * y[0] + y[1] * y[1] + y[2] * y[2] + y[3] * y[3]);
              const float r = 1.0f / sqrtf(ss * (1.0f / 64.0f) + 1e-6f);
              const float g0 = siluf(u2f(gw.x << 16)), g1 = siluf(u2f(gw.x & 0xffff0000u)), g2 = siluf(u2f(gw.y << 16)), g3 = siluf(u2f(gw.y & 0xffff0000u));
              u32x2 o; o.x = pack_bf16(y[0] * r * wr[0] * g0, y[1] * r * wr[1] * g1); o.y = pack_bf16(y[2] * r * wr[2] * g2, y[3] * r * wr[3] * g3);
              *(u32x2*)(P.YS + tl * DM + 512 + c4) = o; }
            { const u32x2 ya = sa[b], yb = sb[b], xw = sx[b], zw = sz[b];
              f32x4 y = {u2f(ya.x << 16) + u2f(yb.x << 16), u2f(ya.x & 0xffff0000u) + u2f(yb.x & 0xffff0000u), u2f(ya.y << 16) + u2f(yb.y << 16), u2f(ya.y & 0xffff0000u) + u2f(yb.y & 0xffff0000u)};
              y[0] = (y[0] + Dh * u2f(xw.x << 16)) * siluf(u2f(zw.x << 16)); y[1] = (y[1] + Dh * u2f(xw.x & 0xffff0000u)) * siluf(u2f(zw.x & 0xffff0000u));
              y[2] = (y[2] + Dh * u2f(xw.y << 16)) * siluf(u2f(zw.y << 16)); y[3] = (y[3] + Dh * u2f(xw.y & 0xffff0000u)) * siluf(u2f(zw.y & 0xffff0000u));
              float ss = y[0] * y[0] + y[1] * y[1] + y[2] * y[2] + y[3] * y[3]; ss = wave_sum(ss);
              const float r = 1.0f / sqrtf(ss * (1.0f / 256.0f) + 1e-6f);
              u32x2 o; o.x = pack_bf16(y[0] * r * ws[0], y[1] * r * ws[1]); o.y = pack_bf16(y[2] * r * ws[2], y[3] * r * ws[3]);
              *(u32x2*)(P.YS + tl * DM + 768 + c4) = o; } }
    }
}

#define KEY_INSERT(v, x) do { _Pragma("unroll") for (int k_ = 15; k_ >= 1; --k_) v[k_] = __builtin_amdgcn_fmed3f(v[k_ - 1], v[k_], (x)); v[0] = fmaxf(v[0], (x)); } while (0)
#define KEY_MERGE_XOR(v, m) do { float ov_[16]; _Pragma("unroll") for (int k_ = 0; k_ < 16; ++k_) ov_[k_] = __shfl_xor(v[k_], m); \
        _Pragma("unroll") for (int k_ = 0; k_ < 16; ++k_) v[k_] = fmaxf(v[k_], ov_[15 - k_]); \
        _Pragma("unroll") for (int st_ = 8; st_ >= 1; st_ >>= 1) { _Pragma("unroll") for (int i_ = 0; i_ < 16; ++i_) { if ((i_ & st_) == 0) { const float hi_ = fmaxf(v[i_], v[i_ + st_]), lo_ = fminf(v[i_], v[i_ + st_]); v[i_] = hi_; v[i_ + st_] = lo_; } } } } while (0)
__device__ __forceinline__ void dev_peer_topk(const Params& P, int ck, int l, int tid) {
    const int wave = tid >> 6, lane = tid & 63, lq = lane & 15, q4 = lane >> 4; const int T = P.cfg.ck_nseq[ck] * P.cfg.ck_L[ck];
    pg8::StaticOrder SO; SO.init(T, 2048, gridDim.x, blockIdx.x); pg8::Unit un;
    for (int ui = 0; SO.next(ui, un); ++ui) {
        const int h = un.pn; const size_t tl0 = (size_t)un.pm * 256 + wave * 32;
        const unsigned qm0 = (unsigned)(-(int)(q4 == 0)), qm1 = (unsigned)(-(int)(q4 == 1)), qm2 = (unsigned)(-(int)(q4 == 2)), qm3 = (unsigned)(-(int)(q4 == 3));
        float v1[2][16], v2[2][16];
        bf16x8 qfa[2][2][4];
#pragma unroll
        for (int sub = 0; sub < 2; ++sub)
#pragma unroll
            for (int tt = 0; tt < 2; ++tt)
#pragma unroll
                for (int ks = 0; ks < 4; ++ks) qfa[sub][tt][ks] = *(const bf16x8*)(P.PROJ + (tl0 + tt * 16 + lq) * 2048 + (h * 2 + sub) * 128 + 8 * q4 + ks * 32);
#pragma unroll
        for (int sub = 0; sub < 2; ++sub) {
            const int hc = h * 2 + sub; const bf16_t* kb = P.keys_bf + ((size_t)l * 16 + hc) * 128 * 128;
            bf16x8 qf[2][4];
#pragma unroll
            for (int tt = 0; tt < 2; ++tt)
#pragma unroll
                for (int ks = 0; ks < 4; ++ks) qf[tt][ks] = qfa[sub][tt][ks];
            float v[2][16];
#pragma unroll
            for (int k = 0; k < 16; ++k) { v[0][k] = -3.0e38f; v[1][k] = -3.0e38f; }
            bf16x8 kfn[4];
#pragma unroll
            for (int ks = 0; ks < 4; ++ks) kfn[ks] = *(const bf16x8*)(kb + (size_t)lq * 128 + ks * 32 + 8 * q4);
#pragma unroll 1
            for (int kt = 0; kt < 8; ++kt) {
                f32x4 s0 = {0.f, 0.f, 0.f, 0.f}, s1 = {0.f, 0.f, 0.f, 0.f}; bf16x8 kfc[4]; const int ktn = kt < 7 ? kt + 1 : 7;
#pragma unroll
                for (int ks = 0; ks < 4; ++ks) { kfc[ks] = kfn[ks]; kfn[ks] = *(const bf16x8*)(kb + (size_t)(ktn * 16 + lq) * 128 + ks * 32 + 8 * q4); }
#pragma unroll
                for (int ks = 0; ks < 4; ++ks) { const bf16x8 kf = kfc[ks];
                    s0 = __builtin_amdgcn_mfma_f32_16x16x32_bf16(kf, qf[0][ks], s0, 0, 0, 0); s1 = __builtin_amdgcn_mfma_f32_16x16x32_bf16(kf, qf[1][ks], s1, 0, 0, 0); }
#pragma unroll
                for (int r = 0; r < 4; ++r) { const unsigned id = (unsigned)(kt * 16 + 4 * q4 + r); const float x0 = u2f((f2u(s0[r]) & ~0x7Fu) | id); KEY_INSERT(v[0], x0); }
                __builtin_amdgcn_sched_barrier(0);
#pragma unroll
                for (int r = 0; r < 4; ++r) { const unsigned id = (unsigned)(kt * 16 + 4 * q4 + r); const float x1 = u2f((f2u(s1[r]) & ~0x7Fu) | id); KEY_INSERT(v[1], x1); }
                __builtin_amdgcn_sched_barrier(0);
            }
#pragma unroll
            for (int tt = 0; tt < 2; ++tt) { KEY_MERGE_XOR(v[tt], 16); KEY_MERGE_XOR(v[tt], 32);
                if (sub == 0) {
#pragma unroll
                    for (int k = 0; k < 16; ++k) v1[tt][k] = v[tt][k]; }
                else {
#pragma unroll
                    for (int k = 0; k < 16; ++k) v2[tt][k] = v[tt][k]; } }
        }
#pragma unroll
        for (int tt = 0; tt < 2; ++tt) {
            float vt[16];
#pragma unroll
            for (int k = 0; k < 16; ++k) vt[k] = -3.0e38f;
            { float w1[16], w2[16];
#pragma unroll
              for (int k = 0; k < 16; ++k) { w1[k] = u2f(f2u(v1[tt][k]) & ~0x7Fu); w2[k] = u2f(f2u(v2[tt][k]) & ~0x7Fu); }
              { const float x = u2f((qm0 & ((f2u(w1[0] + w2[0]) & ~0xFFu) | 0u)) | (qm1 & ((f2u(w1[1] + w2[0]) & ~0xFFu) | 16u)) | (qm2 & ((f2u(w1[2] + w2[0]) & ~0xFFu) | 32u)) | (qm3 & ((f2u(w1[7] + w2[0]) & ~0xFFu) | 112u))); KEY_INSERT(vt, x); }
              { const float x = u2f((qm0 & ((f2u(w1[0] + w2[1]) & ~0xFFu) | 1u)) | (qm1 & ((f2u(w1[1] + w2[1]) & ~0xFFu) | 17u)) | (qm2 & ((f2u(w1[2] + w2[1]) & ~0xFFu) | 33u)) | (qm3 & ((f2u(w1[7] + w2[1]) & ~0xFFu) | 113u))); KEY_INSERT(vt, x); }
              { const float x = u2f((qm0 & ((f2u(w1[0] + w2[2]) & ~0xFFu) | 2u)) | (qm1 & ((f2u(w1[1] + w2[2]) & ~0xFFu) | 18u)) | (qm2 & ((f2u(w1[2] + w2[2]) & ~0xFFu) | 34u)) | (qm3 & ((f2u(w1[8] + w2[0]) & ~0xFFu) | 128u))); KEY_INSERT(vt, x); }
              { const float x = u2f((qm0 & ((f2u(w1[0] + w2[3]) & ~0xFFu) | 3u)) | (qm1 & ((f2u(w1[1] + w2[3]) & ~0xFFu) | 19u)) | (qm2 & ((f2u(w1[2] + w2[3]) & ~0xFFu) | 35u)) | (qm3 & ((f2u(w1[9] + w2[0]) & ~0xFFu) | 144u))); KEY_INSERT(vt, x); }
              { const float x = u2f((qm0 & ((f2u(w1[0] + w2[4]) & ~0xFFu) | 4u)) | (qm1 & ((f2u(w1[1] + w2[4]) & ~0xFFu) | 20u)) | (qm2 & ((f2u(w1[2] + w2[4]) & ~0xFFu) | 36u)) | (qm3 & ((f2u(w1[10] + w2[0]) & ~0xFFu) | 160u))); KEY_INSERT(vt, x); }
              { const float x = u2f((qm0 & ((f2u(w1[0] + w2[5]) & ~0xFFu) | 5u)) | (qm1 & ((f2u(w1[1] + w2[5]) & ~0xFFu) | 21u)) | (qm2 & ((f2u(w1[4] + w2[0]) & ~0xFFu) | 64u)) | (qm3 & ((f2u(w1[11] + w2[0]) & ~0xFFu) | 176u))); KEY_INSERT(vt, x); }
              { const float x = u2f((qm0 & ((f2u(w1[0] + w2[6]) & ~0xFFu) | 6u)) | (qm1 & ((f2u(w1[1] + w2[6]) & ~0xFFu) | 22u)) | (qm2 & ((f2u(w1[4] + w2[1]) & ~0xFFu) | 65u)) | (qm3 & ((f2u(w1[12] + w2[0]) & ~0xFFu) | 192u))); KEY_INSERT(vt, x); }
              { const float x = u2f((qm0 & ((f2u(w1[0] + w2[7]) & ~0xFFu) | 7u)) | (qm1 & ((f2u(w1[1] + w2[7]) & ~0xFFu) | 23u)) | (qm2 & ((f2u(w1[4] + w2[2]) & ~0xFFu) | 66u)) | (qm3 & ((f2u(w1[13] + w2[0]) & ~0xFFu) | 208u))); KEY_INSERT(vt, x); }
              { const float x = u2f((qm0 & ((f2u(w1[0] + w2[8]) & ~0xFFu) | 8u)) | (qm1 & ((f2u(w1[3] + w2[0]) & ~0xFFu) | 48u)) | (qm2 & ((f2u(w1[5] + w2[0]) & ~0xFFu) | 80u)) | (qm3 & ((f2u(w1[14] + w2[0]) & ~0xFFu) | 224u))); KEY_INSERT(vt, x); }
              { const float x = u2f((qm0 & ((f2u(w1[0] + w2[9]) & ~0xFFu) | 9u)) | (qm1 & ((f2u(w1[3] + w2[1]) & ~0xFFu) | 49u)) | (qm2 & ((f2u(w1[5] + w2[1]) & ~0xFFu) | 81u)) | (qm3 & ((f2u(w1[15] + w2[0]) & ~0xFFu) | 240u))); KEY_INSERT(vt, x); }
              { const float x = u2f((qm0 & ((f2u(w1[0] + w2[10]) & ~0xFFu) | 10u)) | (qm1 & ((f2u(w1[3] + w2[2]) & ~0xFFu) | 50u)) | (qm2 & ((f2u(w1[6] + w2[0]) & ~0xFFu) | 96u)) | (qm3 & 0xFF7FFFFFu)); KEY_INSERT(vt, x); }
              { const float x = u2f((qm0 & ((f2u(w1[0] + w2[11]) & ~0xFFu) | 11u)) | (qm1 & ((f2u(w1[3] + w2[3]) & ~0xFFu) | 51u)) | (qm2 & ((f2u(w1[6] + w2[1]) & ~0xFFu) | 97u)) | (qm3 & 0xFF7FFFFFu)); KEY_INSERT(vt, x); }
              { const float x = u2f((qm0 & ((f2u(w1[0] + w2[12]) & ~0xFFu) | 12u)) | (qm1 & 0xFF7FFFFFu) | (qm2 & 0xFF7FFFFFu) | (qm3 & 0xFF7FFFFFu)); KEY_INSERT(vt, x); }
              { const float x = u2f((qm0 & ((f2u(w1[0] + w2[13]) & ~0xFFu) | 13u)) | (qm1 & 0xFF7FFFFFu) | (qm2 & 0xFF7FFFFFu) | (qm3 & 0xFF7FFFFFu)); KEY_INSERT(vt, x); }
              { const float x = u2f((qm0 & ((f2u(w1[0] + w2[14]) & ~0xFFu) | 14u)) | (qm1 & 0xFF7FFFFFu) | (qm2 & 0xFF7FFFFFu) | (qm3 & 0xFF7FFFFFu)); KEY_INSERT(vt, x); }
              { const float x = u2f((qm0 & ((f2u(w1[0] + w2[15]) & ~0xFFu) | 15u)) | (qm1 & 0xFF7FFFFFu) | (qm2 & 0xFF7FFFFFu) | (qm3 & 0xFF7FFFFFu)); KEY_INSERT(vt, x); }
            }
            KEY_MERGE_XOR(vt, 16); KEY_MERGE_XOR(vt, 32);
            const float top = u2f(f2u(vt[0]) & ~0xFFu); float den = 0.f;
#pragma unroll
            for (int k = 0; k < 16; ++k) den += fexpf(u2f(f2u(vt[k]) & ~0xFFu) - top);
            const float rd = 1.0f / den; f32x4 gout; u32x4 iout;
#pragma unroll
            for (int r = 0; r < 4; ++r) { const unsigned kbits = (qm0 & f2u(vt[r])) | (qm1 & f2u(vt[4 + r])) | (qm2 & f2u(vt[8 + r])) | (qm3 & f2u(vt[12 + r])); const int a = (kbits >> 4) & 15, b = kbits & 15;
                unsigned ia = 0u, ib = 0u;
#pragma unroll
                for (int k = 0; k < 16; ++k) { ia |= (unsigned)(-(int)(a == k)) & f2u(v1[tt][k]); ib |= (unsigned)(-(int)(b == k)) & f2u(v2[tt][k]); }
                ia &= 0x7Fu; ib &= 0x7Fu;
                iout[r] = ia * 128u + ib; gout[r] = fexpf(u2f(kbits & ~0xFFu) - top) * rd; }
            *(f32x4*)(P.PG + (tl0 + tt * 16 + lq) * 128 + h * 16 + 4 * q4) = gout; *(u32x4*)(P.PIDX + (tl0 + tt * 16 + lq) * 128 + h * 16 + 4 * q4) = iout;
        }
    }
}
constexpr int AT_ST = 16384;
__device__ __forceinline__ void dev_attn(const Params& P, int ck, int l, LAS unsigned char* lds, int tid) {
    const int wave = __builtin_amdgcn_readfirstlane(tid >> 6), lane = tid & 63, lq = lane & 15, q4 = lane >> 4; const int L = P.cfg.ck_L[ck], nseq = P.cfg.ck_nseq[ck];
    const int nqb = L / 256, nunit = nseq * 4 * nqb, nkt = L / 64;
    const float lam = P.lam[l * 4 + 0], lam_init = P.lam[l * 4 + 1]; const float LOG2E = 1.4426950408889634f; const float Ms = P.lam[l * 4 + 2] * LOG2E;
    const int drow = wave * 8 + (lane >> 3), dch = (lane & 7) ^ (lane >> 3);
    for (int u0 = blockIdx.x; u0 < nunit; u0 += gridDim.x) {
        const int u = (nunit & 7) == 0 ? (u0 & 7) * (nunit >> 3) + (u0 >> 3) : u0;
        const int qb = u % nqb, head = (u / nqb) & 3, sl = u / (nqb * 4);
        const float nsl = -exp2f(-2.0f * (float)(head + 1)) * LOG2E;
        const char* ksrc = (const char*)(P.PROJ + ((size_t)sl * L + drow) * NPROJ + C_DAK + head * 64) + dch * 16;
        const char* vsrc = (const char*)(P.VT + ((size_t)sl * 256 + head * 64 + drow) * L) + dch * 16;
        bf16x8 qf[2][2];
#pragma unroll
        for (int qt = 0; qt < 2; ++qt)
#pragma unroll
            for (int sub = 0; sub < 2; ++sub) qf[qt][sub] = *(const bf16x8*)(P.PROJ + ((size_t)sl * L + qb * 256 + wave * 32 + qt * 16 + lq) * NPROJ + C_DAQ + head * 64 + sub * 32 + q4 * 8);
        f32x4 O[2][2][4]; float lsum[2][2];
#pragma unroll
        for (int qt = 0; qt < 2; ++qt)
#pragma unroll
            for (int sub = 0; sub < 2; ++sub) { lsum[qt][sub] = 0.f;
#pragma unroll
                for (int vt = 0; vt < 4; ++vt) O[qt][sub][vt] = (f32x4){0.f, 0.f, 0.f, 0.f}; }
#define AT_ISSUE(kt_) do { const int kk_ = (kt_) < nkt ? (kt_) : nkt - 1; LAS unsigned char* sb_ = lds + ((kt_) & 3) * AT_ST + wave * 1024; \
        __builtin_amdgcn_global_load_lds((const unsigned*)(ksrc + (size_t)kk_ * 64 * NPROJ * 2), (LAS unsigned*)sb_, 16, 0, 0); \
        __builtin_amdgcn_global_load_lds((const unsigned*)(vsrc + (size_t)kk_ * 128), (LAS unsigned*)(sb_ + 8192), 16, 0, 0); } while (0)
        __syncthreads();
        AT_ISSUE(0); AT_ISSUE(1); AT_ISSUE(2);
        for (int kt = 0; kt < nkt; ++kt) {
            asm volatile("s_waitcnt vmcnt(4) lgkmcnt(0)" ::: "memory");
            __builtin_amdgcn_s_barrier();
            asm volatile("" ::: "memory");
            AT_ISSUE(kt + 3);
            const LAS unsigned char* Kt = lds + (kt & 3) * AT_ST; const LAS unsigned char* Vt = Kt + 8192;
#pragma unroll
            for (int h32 = 0; h32 < 2; ++h32) {
                bf16x8 vf[4];
#pragma unroll
                for (int vt = 0; vt < 4; ++vt) { const int vd = vt * 16 + lq; const int c0 = h32 * 4 + (q4 >> 1); const LAS unsigned char* vr = Vt + vd * 128 + (q4 & 1) * 8;
                    const u32x2 lo = *(const LAS u32x2*)(vr + ((c0 ^ (vd & 7)) << 4)), hi = *(const LAS u32x2*)(vr + (((c0 + 2) ^ (vd & 7)) << 4)); vf[vt] = __builtin_bit_cast(bf16x8, (u32x4){lo.x, lo.y, hi.x, hi.y}); }
                bf16x8 kf[2][2];
#pragma unroll
                for (int sub = 0; sub < 2; ++sub)
#pragma unroll
                    for (int kk = 0; kk < 2; ++kk) { const int r = h32 * 32 + kk * 16 + lq; kf[sub][kk] = *(const LAS bf16x8*)(Kt + r * 128 + (((sub * 4 + q4) ^ (r & 7)) << 4)); }
#pragma unroll
                for (int qt = 0; qt < 2; ++qt) {
                    const float rel = (float)(kt * 64 + h32 * 32 + 4 * q4 - (qb * 256 + wave * 32 + qt * 16 + lq));
                    float bias[8];
#pragma unroll
                    for (int r = 0; r < 4; ++r) { bias[r] = fabsf(rel + (float)r) * nsl - Ms; bias[4 + r] = fabsf(rel + (float)(16 + r)) * nsl - Ms; }
#pragma unroll
                    for (int sub = 0; sub < 2; ++sub) {
                        const f32x4 bz0 = {bias[0], bias[1], bias[2], bias[3]}, bz1 = {bias[4], bias[5], bias[6], bias[7]};
                        const f32x4 s0 = __builtin_amdgcn_mfma_f32_16x16x32_bf16(kf[sub][0], qf[qt][sub], bz0, 0, 0, 0), s1 = __builtin_amdgcn_mfma_f32_16x16x32_bf16(kf[sub][1], qf[qt][sub], bz1, 0, 0, 0);
                        float p[8];
#pragma unroll
                        for (int r = 0; r < 4; ++r) { p[r] = __builtin_amdgcn_exp2f(s0[r]); p[4 + r] = __builtin_amdgcn_exp2f(s1[r]); }
                        lsum[qt][sub] += ((p[0] + p[1]) + (p[2] + p[3])) + ((p[4] + p[5]) + (p[6] + p[7]));
                        u32x4 pw; pw.x = pack_bf16(p[0], p[1]); pw.y = pack_bf16(p[2], p[3]); pw.z = pack_bf16(p[4], p[5]); pw.w = pack_bf16(p[6], p[7]);
                        const bf16x8 pb = __builtin_bit_cast(bf16x8, pw);
#pragma unroll
                        for (int vt = 0; vt < 4; ++vt) O[qt][sub][vt] = __builtin_amdgcn_mfma_f32_16x16x32_bf16(vf[vt], pb, O[qt][sub][vt], 0, 0, 0);
                    }
                }
            }
        }
        asm volatile("s_waitcnt vmcnt(0)" ::: "memory");
#undef AT_ISSUE
#pragma unroll
        for (int qt = 0; qt < 2; ++qt) {
            float l1 = lsum[qt][0], l2 = lsum[qt][1];
            l1 += __shfl_xor(l1, 16); l1 += __shfl_xor(l1, 32); l2 += __shfl_xor(l2, 16); l2 += __shfl_xor(l2, 32);
            const float r1 = 1.0f / l1, r2 = lam / l2; float ss = 0.f; f32x4 o[4];
#pragma unroll
            for (int vt = 0; vt < 4; ++vt) { o[vt] = O[qt][0][vt] * r1 - O[qt][1][vt] * r2; ss += o[vt][0] * o[vt][0] + o[vt][1] * o[vt][1] + o[vt][2] * o[vt][2] + o[vt][3] * o[vt][3]; }
            ss += __shfl_xor(ss, 16); ss += __shfl_xor(ss, 32);
            const float rn = (1.0f / sqrtf(ss * (1.0f / 64.0f) + 1e-6f)) * (1.0f - lam_init);
            const size_t tl = (size_t)sl * L + qb * 256 + wave * 32 + qt * 16 + lq;
#pragma unroll
            for (int vt = 0; vt < 4; ++vt) { const int vd = vt * 16 + 4 * q4; const f32x4 w = *(const f32x4*)(P.in[IN_DA_SUBLN_W] + l * 256 + head * 64 + vd);
                u32x2 ow; ow.x = pack_bf16(o[vt][0] * rn * w[0], o[vt][1] * rn * w[1]); ow.y = pack_bf16(o[vt][2] * rn * w[2], o[vt][3] * rn * w[3]);
                *(u32x2*)(P.YS + tl * DM + 256 + head * 64 + vd) = ow; }
        }
    }
}
constexpr int TILE_LD = 72;
__device__ __forceinline__ void tile_put_col8(LAS unsigned short* tile, int t, int cg, const float* v) {
#pragma unroll
    for (int j = 0; j < 8; ++j) tile[(cg * 8 + j) * TILE_LD + t] = f2bf(v[j]);
}
__device__ __forceinline__ void tile_put_col8_raw(LAS unsigned short* tile, int t, int cg, const u32x4 w) {
    tile[(cg * 8 + 0) * TILE_LD + t] = (unsigned short)(w.x & 0xffffu); tile[(cg * 8 + 1) * TILE_LD + t] = (unsigned short)(w.x >> 16);
    tile[(cg * 8 + 2) * TILE_LD + t] = (unsigned short)(w.y & 0xffffu); tile[(cg * 8 + 3) * TILE_LD + t] = (unsigned short)(w.y >> 16);
    tile[(cg * 8 + 4) * TILE_LD + t] = (unsigned short)(w.z & 0xffffu); tile[(cg * 8 + 5) * TILE_LD + t] = (unsigned short)(w.z >> 16);
    tile[(cg * 8 + 6) * TILE_LD + t] = (unsigned short)(w.w & 0xffffu); tile[(cg * 8 + 7) * TILE_LD + t] = (unsigned short)(w.w >> 16);
}
constexpr int TNB = 4, TILE_SZ = 64 * TILE_LD;
__device__ __forceinline__ u32x4 sel0(const bool keep, const u32x4 w) { u32x4 r; r.x = keep ? w.x : 0u; r.y = keep ? w.y : 0u; r.z = keep ? w.z : 0u; r.w = keep ? w.w : 0u; return r; }
__device__ __forceinline__ void dev_pre_tiles(const Params& P, int ck, int l, LAS unsigned short* tile, int tid) {
    const int L = P.cfg.ck_L[ck], T = P.cfg.ck_nseq[ck] * L; const int tq = tid >> 3, g8 = tid & 7; const int ngrp = (T / 64 / TNB) * 16;
    for (int u = blockIdx.x; u < ngrp; u += gridDim.x) {
        const int ctile = u & 15, tg = u >> 4; const int tlb = tg * TNB * 64, sl = tlb / L, tb = tlb % L;
        if (ctile < 12) { const int c = ctile * 64 + g8 * 8; const float* w = P.in[IN_HY_CONV_W] + (size_t)l * 3 * 768 + c; const float* bb = P.in[IN_HY_CONV_B] + l * 768 + c;
            u32x4 r0[TNB], r1[TNB], r2[TNB];
#pragma unroll
            for (int b = 0; b < TNB; ++b) { const int t = tb + b * 64 + tq; const bf16_t* p = P.PROJ + (size_t)(tlb + b * 64 + tq) * NPROJ + C_HY + c;
                r1[b] = *(const u32x4*)p; r0[b] = *(const u32x4*)(p - (t > 0 ? NPROJ : 0)); r2[b] = *(const u32x4*)(p + (t + 1 < L ? NPROJ : 0)); }
            const f32x4 b0 = *(const f32x4*)bb, b1 = *(const f32x4*)(bb + 4), wa0 = *(const f32x4*)w, wa1 = *(const f32x4*)(w + 4), wb0 = *(const f32x4*)(w + 768), wb1 = *(const f32x4*)(w + 772), wc0 = *(const f32x4*)(w + 1536), wc1 = *(const f32x4*)(w + 1540);
#pragma unroll
            for (int b = 0; b < TNB; ++b) { const int t = tb + b * 64 + tq; float x0[8], x1[8], x2[8], acc[8];
                unpack8(sel0(t > 0, r0[b]), x0); unpack8(r1[b], x1); unpack8(sel0(t + 1 < L, r2[b]), x2);
#pragma unroll
                for (int j = 0; j < 4; ++j) { acc[j] = b0[j] + wb0[j] * x1[j] + wa0[j] * x0[j] + wc0[j] * x2[j]; acc[4 + j] = b1[j] + wb1[j] * x1[4 + j] + wa1[j] * x0[4 + j] + wc1[j] * x2[4 + j]; }
                tile_put_col8(tile + b * TILE_SZ, tq, g8, acc); }
        } else { u32x4 r[TNB];
#pragma unroll
            for (int b = 0; b < TNB; ++b) r[b] = *(const u32x4*)(P.PROJ + (size_t)(tlb + b * 64 + tq) * NPROJ + C_DAV + (ctile - 12) * 64 + g8 * 8);
#pragma unroll
            for (int b = 0; b < TNB; ++b) tile_put_col8_raw(tile + b * TILE_SZ, tq, g8, r[b]); }
        __syncthreads();
        bf16_t* dst = ctile < 12 ? P.HYT + ((size_t)sl * 768 + ctile * 64 + tq) * L + tb + g8 * 8 : P.VT + ((size_t)sl * 256 + (ctile - 12) * 64 + tq) * L + tb + g8 * 8;
#pragma unroll
        for (int b = 0; b < TNB; ++b) *(u32x4*)(dst + b * 64) = *(const LAS u32x4*)(tile + b * TILE_SZ + tq * TILE_LD + g8 * 8);
        __syncthreads();
    }
}
__device__ __forceinline__ void dev_scan_tiles(const Params& P, int ck, int l, LAS unsigned short* tile, int tid) {
    const int L = P.cfg.ck_L[ck], T = P.cfg.ck_nseq[ck] * L; const int tq = tid >> 3, g8 = tid & 7; const int ngrp = (T / 64 / TNB) * 14;
    for (int u = blockIdx.x; u < ngrp; u += gridDim.x) {
        const int ctile = u % 14, tg = u / 14; const int tlb = tg * TNB * 64, sl = tlb / L, tb = tlb % L;
        if (ctile < 6) { const int col = ctile < 2 ? C_RK + ctile * 64 + g8 * 8 : C_RV + (ctile - 2) * 64 + g8 * 8; u32x4 r[TNB];
#pragma unroll
            for (int b = 0; b < TNB; ++b) r[b] = *(const u32x4*)(P.PROJ + (size_t)(tlb + b * 64 + tq) * NPROJ + col);
#pragma unroll
            for (int b = 0; b < TNB; ++b) tile_put_col8_raw(tile + b * TILE_SZ, tq, g8, r[b]); }
        else { const int c = (ctile - 6) * 64 + g8 * 8; const float* w = P.in[IN_SSM_CONV_W] + (size_t)l * 5 * 512 + c; const float* bb = P.in[IN_SSM_CONV_B] + l * 512 + c;
            u32x4 r[TNB][5];
#pragma unroll
            for (int b = 0; b < TNB; ++b) { const int t = tb + b * 64 + tq; const bf16_t* p = P.PROJ + (size_t)(tlb + b * 64 + tq) * NPROJ + C_SXBC + c;
#pragma unroll
                for (int k = 0; k < 5; ++k) { const int tt2 = t + k - 2; r[b][k] = *(const u32x4*)(p + ((tt2 >= 0 && tt2 < L) ? (k - 2) * NPROJ : 0)); } }
            const f32x4 b0 = *(const f32x4*)bb, b1 = *(const f32x4*)(bb + 4);
#pragma unroll
            for (int b = 0; b < TNB; ++b) { const int t = tb + b * 64 + tq; float acc[8];
#pragma unroll
                for (int j = 0; j < 4; ++j) { acc[j] = b0[j]; acc[4 + j] = b1[j]; }
#pragma unroll
                for (int k = 0; k < 5; ++k) { const int tt2 = t + k - 2; float x[8]; unpack8(sel0(tt2 >= 0 && tt2 < L, r[b][k]), x); const f32x4 w0 = *(const f32x4*)(w + k * 512), w1 = *(const f32x4*)(w + k * 512 + 4);
#pragma unroll
                    for (int j = 0; j < 4; ++j) { acc[j] += w0[j] * x[j]; acc[4 + j] += w1[j] * x[4 + j]; } }
#pragma unroll
                for (int j = 0; j < 8; ++j) acc[j] = siluf(acc[j]);
                u32x4 o; o.x = pack_bf16(acc[0], acc[1]); o.y = pack_bf16(acc[2], acc[3]); o.z = pack_bf16(acc[4], acc[5]); o.w = pack_bf16(acc[6], acc[7]);
                *(u32x4*)(P.XBC + (size_t)(tlb + b * 64 + tq) * 512 + c) = o;
                if (ctile < 12) tile_put_col8_raw(tile + b * TILE_SZ, tq, g8, o); } }
        __syncthreads();
        if (ctile < 12) { bf16_t* dst = ctile < 2 ? P.RKT + ((size_t)sl * 128 + ctile * 64 + tq) * L : ctile < 6 ? P.RVT + ((size_t)sl * 256 + (ctile - 2) * 64 + tq) * L : P.XT + ((size_t)sl * 384 + (ctile - 6) * 64 + tq) * L;
#pragma unroll
            for (int b = 0; b < TNB; ++b) *(u32x4*)(dst + tb + b * 64 + g8 * 8) = *(const LAS u32x4*)(tile + b * TILE_SZ + tq * TILE_LD + g8 * 8); }
        __syncthreads();
    }
}
__device__ __forceinline__ void dev_hyout_tiles(const Params& P, int ck, LAS unsigned short* tile, int tid) {
    const int L = P.cfg.ck_L[ck], T = P.cfg.ck_nseq[ck] * L; const int tq = tid >> 3, g8 = tid & 7; const int ngrp = (T / 64 / TNB) * 4;
    for (int u = blockIdx.x; u < ngrp; u += gridDim.x) {
        const int ctile = u & 3, tg = u >> 2; const int tlb = tg * TNB * 64, sl = tlb / L, tb = tlb % L; u32x4 r[TNB];
#pragma unroll
        for (int b = 0; b < TNB; ++b) r[b] = *(const u32x4*)(P.HYT + ((size_t)sl * 768 + ctile * 64 + tq) * L + tb + b * 64 + g8 * 8);
#pragma unroll
        for (int b = 0; b < TNB; ++b) tile_put_col8_raw(tile + b * TILE_SZ, tq, g8, r[b]);
        __syncthreads();
#pragma unroll
        for (int b = 0; b < TNB; ++b) *(u32x4*)(P.YS + (size_t)(tlb + b * 64 + tq) * DM + ctile * 64 + g8 * 8) = *(const LAS u32x4*)(tile + b * TILE_SZ + tq * TILE_LD + g8 * 8);
        __syncthreads();
    }
}
__device__ __forceinline__ void dev_transpose_tile(const float* src, int ld_src, bf16_t* dst, int ld_dst, int r0, int c0, LAS float* tile, int tid) {
    const int tx = tid & 63, ty = tid >> 6;
#pragma unroll
    for (int i = 0; i < 8; ++i) tile[(ty + 8 * i) * 65 + tx] = src[(size_t)(r0 + ty + 8 * i) * ld_src + c0 + tx];
    __syncthreads();
#pragma unroll
    for (int i = 0; i < 8; ++i) dst[(size_t)(c0 + ty + 8 * i) * ld_dst + r0 + tx] = f2bf(tile[tx * 65 + ty + 8 * i]);
    __syncthreads();
}
__device__ __forceinline__ void dev_gt(const Params& P, long gtid, long gstride) {
    constexpr int NCH = 32;
    for (long w = gtid; w < (long)P.cfg.depth * 2 * 512 * NCH; w += gstride) {
        const int oc = w & 511, ch = (w >> 9) % NCH; const int lli = (int)((w >> 9) / NCH); const int l = lli >> 1, li = lli & 1;
        const int L = P.cfg.L_len[li]; const int ngx = (2 * L + 32) / 16, xpc = (ngx + NCH - 1) / NCH; const int xg0 = ch * xpc, xg1 = (xg0 + xpc) < ngx ? (xg0 + xpc) : ngx;
        const int o = oc >> 8, c = oc & 255;
        const float* fs = P.fsum + (size_t)lli * 65536 + o * 512 + c; float ssf = 0.f, ssb = 0.f;
#pragma unroll 16
        for (int k = 0; k < 64; ++k) { ssf += fs[k * 1024]; ssb += fs[k * 1024 + 256]; }
        const float scf = 1.0f / sqrtf(ssf + 1e-6f), scb = 1.0f / sqrtf(ssb + 1e-6f);
        bf16_t* row = P.GT + gt_base(P, l, li, oc);
#pragma unroll 2
        for (int xg = xg0; xg < xg1; ++xg) {
            const int x0 = xg * 16, d0 = L + 15 - x0; const bool fwd = d0 >= 15; const float sc = fwd ? scf : scb;
            const float* f = P.filt + filt_base(P, l, li) + o * 512 + (fwd ? 0 : 256) + c;
            float v[16];
#pragma unroll
            for (int j = 0; j < 16; ++j) { const int d = d0 - j; const int ad = d >= 0 ? d : -d; const float fv = f[(size_t)(ad < L ? ad : 0) * 1024]; v[j] = ad < L ? fv * sc : 0.f; }
            u32x4 w0, w1;
            w0.x = pack_bf16(v[0], v[1]); w0.y = pack_bf16(v[2], v[3]); w0.z = pack_bf16(v[4], v[5]); w0.w = pack_bf16(v[6], v[7]);
            w1.x = pack_bf16(v[8], v[9]); w1.y = pack_bf16(v[10], v[11]); w1.z = pack_bf16(v[12], v[13]); w1.w = pack_bf16(v[14], v[15]);
            *(u32x4*)(row + x0) = w0; *(u32x4*)(row + x0 + 8) = w1;
        }
    }
}
__device__ __forceinline__ void dev_filt(const Params& P, int tid) {
    const int wave = tid >> 6, lane = tid & 63; const int L0 = P.cfg.L_len[0], L1 = P.cfg.L_len[1], Lmax = P.cfg.Lmax;
    const int n0 = L0 / 8 * 4, per_l = (L0 + L1) / 8 * 4; const int n = P.cfg.depth * per_l;
    for (int wi0 = blockIdx.x * 8 + wave; wi0 < n; wi0 += gridDim.x * 8) {
        const int wi = __builtin_amdgcn_readfirstlane(wi0);
        const int l = wi / per_l, r = wi % per_l; const int li = r >= n0 ? 1 : 0; const int r2 = li ? r - n0 : r; const int cq = r2 & 3, pos0 = (r2 >> 2) * 8; const int L = li ? L1 : L0;
        const long pr0 = (long)(l * 2 + li) * Lmax + pos0;
        const float* hp = P.hid2 + (pr0 + (lane >> 3)) * 64 + (lane & 7) * 8;
        const u32x4 h0 = *(const u32x4*)hp, h1 = *(const u32x4*)(hp + 4);
        int hreg[8]; hreg[0] = (int)h0.x; hreg[1] = (int)h0.y; hreg[2] = (int)h0.z; hreg[3] = (int)h0.w; hreg[4] = (int)h1.x; hreg[5] = (int)h1.y; hreg[6] = (int)h1.z; hreg[7] = (int)h1.w;
        const int c4 = cq * 64 + lane; const float* w3 = P.in[IN_HF_W3] + (size_t)l * 64 * 1024 + c4 * 4;
        f32x4 acc[8], wn[8];
#pragma unroll
        for (int p = 0; p < 8; ++p) acc[p] = (f32x4){0.f, 0.f, 0.f, 0.f};
#pragma unroll
        for (int e = 0; e < 8; ++e) wn[e] = *(const f32x4*)(w3 + e * 1024);
#pragma unroll 1
        for (int jo = 0; jo < 8; ++jo) {
            f32x4 w[8]; const int jn = jo < 7 ? jo + 1 : 7;
#pragma unroll
            for (int e = 0; e < 8; ++e) { w[e] = wn[e]; wn[e] = *(const f32x4*)(w3 + (jn * 8 + e) * 1024); }
#pragma unroll
            for (int e = 0; e < 8; ++e)
#pragma unroll
                for (int p = 0; p < 8; ++p) { const float sv = __builtin_bit_cast(float, __builtin_amdgcn_readlane(hreg[e], p * 8 + jo)); acc[p] += w[e] * sv; }
        }
        const float mn = -3.0701134573253945f, mx = -15.350567286626972f;
        float delta[4];
#pragma unroll
        for (int e = 0; e < 4; ++e) delta[e] = fabsf(mn + (float)((c4 * 4 + e) & 255) * ((mx - mn) / 255.0f));
        float* fo = P.filt + filt_base(P, l, li) + (size_t)pos0 * 1024 + c4 * 4;
#pragma unroll
        for (int p = 0; p < 8; ++p) { const float t = (float)(pos0 + p) / (float)(L - 1); f32x4 o;
#pragma unroll
            for (int e = 0; e < 4; ++e) o[e] = acc[p][e] * fexpf(-t * delta[e]);
            *(f32x4*)(fo + (size_t)p * 1024) = o; }
    }
}
__device__ __forceinline__ void dev_ada(const Params& P, LAS float* lds, int tid) {
    constexpr int SH = 12;
    const int wave = tid >> 6, lane = tid & 63; const int ns = P.cfg.nseq_total, nh = (ns + SH - 1) / SH;
    for (int i = tid; i < ns * 256; i += NTHREADS) *(LAS f32x4*)(lds + 4 * i) = *(const f32x4*)(P.silu_c + 4 * i);
    __syncthreads();
    LAS float* red = lds + 24 * 1024;
    const int nitem = P.cfg.depth * 96 * nh;
    for (int it = blockIdx.x; it < nitem; it += gridDim.x) {
        int itm = it; if (nh == 2 && (nitem & 15) == 0) { const int x = it & 7, k = it >> 3; itm = (((k >> 1) * 8 + x) << 1) | (k & 1); }
        const int half = itm % nh, jb = (itm / nh) % 96, l = itm / (nh * 96); const int s0 = half * SH;
        const float* w = P.in[IN_ADA_W] + ((size_t)l * DM + wave * 128) * 6144 + jb * 64 + lane;
        float acc[SH];
#pragma unroll
        for (int q = 0; q < SH; ++q) acc[q] = 0.f;
#pragma unroll 1
        for (int k0 = 0; k0 < 128; k0 += 16) { float wv[16];
#pragma unroll
            for (int e = 0; e < 16; ++e) wv[e] = w[(size_t)(k0 + e) * 6144];
#pragma unroll
            for (int e4 = 0; e4 < 4; ++e4) {
#pragma unroll
                for (int q = 0; q < SH; ++q) { const int sq = (s0 + q < ns) ? s0 + q : ns - 1; const f32x4 cv = *(const LAS f32x4*)(lds + sq * 1024 + wave * 128 + k0 + 4 * e4);
                    acc[q] += cv[0] * wv[4 * e4] + cv[1] * wv[4 * e4 + 1] + cv[2] * wv[4 * e4 + 2] + cv[3] * wv[4 * e4 + 3]; }
                __builtin_amdgcn_sched_barrier(0); } }
#pragma unroll
        for (int q = 0; q < SH; ++q) red[(wave * SH + q) * 64 + lane] = acc[q];
        __syncthreads();
        for (int o = tid; o < SH * 64; o += NTHREADS) { const int q = o >> 6, j = o & 63; float v = 0.f;
#pragma unroll
            for (int wv_ = 0; wv_ < 8; ++wv_) v += red[(wv_ * SH + q) * 64 + j];
            if (s0 + q < ns) P.ada[((size_t)l * ns + s0 + q) * 6144 + jb * 64 + j] = v + P.in[IN_ADA_B][l * 6144 + jb * 64 + j]; }
        __syncthreads();
    }
}
struct WTile { const float* src; bf16_t* dst; int ld_src, ld_dst; };
__device__ __forceinline__ WTile wtile_of(const Params& P, int t) {
    const int per_layer = 2816; const int l = t / per_layer; int u = t % per_layer; WTile w; int r0, c0;
    if (u < 768) { w.src = P.in[IN_W_IN] + (size_t)l * DM * NIN; w.ld_src = NIN; w.dst = P.wcat_t + (size_t)l * NCAT * DM; w.ld_dst = DM; r0 = (u / 48) * 64; c0 = (u % 48) * 64; }
    else if (u < 1792) { u -= 768; const int i = u >> 8, v = u & 255; w.src = P.in[IN_W_GATE] + ((size_t)l * 4 + i) * DM * DM; w.ld_src = DM; w.dst = P.wcat_t + ((size_t)l * NCAT + NPROJ + i * 1024) * DM; w.ld_dst = DM; r0 = (v >> 4) * 64; c0 = (v & 15) * 64; }
    else if (u < 2048) { u -= 1792; const int i = u >> 6, v = u & 63; w.src = P.in[IN_W_BRANCH] + ((size_t)l * 4 + i) * 256 * DM; w.ld_src = DM; w.dst = P.wbr_t + ((size_t)l * 4096 + i * 1024) * 256; w.ld_dst = 256; r0 = (v >> 4) * 64; c0 = (v & 15) * 64; }
    else if (u < 2304) { u -= 2048; w.src = P.in[IN_W_OUT] + (size_t)l * DM * DM; w.ld_src = DM; w.dst = P.wout_t + (size_t)l * DM * DM; w.ld_dst = DM; r0 = (u >> 4) * 64; c0 = (u & 15) * 64; }
    else { u -= 2304; w.src = P.in[IN_PEER_WQ] + (size_t)l * DM * 2048; w.ld_src = 2048; w.dst = P.wq_t + (size_t)l * 2048 * DM; w.ld_dst = DM; r0 = (u >> 5) * 64; c0 = (u & 31) * 64; }
    w.src += (size_t)r0 * w.ld_src + c0; w.dst += (size_t)c0 * w.ld_dst + r0;
    return w;
}
__device__ __forceinline__ void dev_prologue_weights(const Params& P, LAS float* tile, int tid) {
    constexpr int WB = 4, WT = 64 * 65;
    const int total = P.cfg.depth * 2816; const int tx = tid & 63, ty = tid >> 6;
    for (int t0 = blockIdx.x; t0 < total; t0 += gridDim.x * WB) {
        float v[WB][8];
#pragma unroll
        for (int b = 0; b < WB; ++b) { const int t = t0 + b * gridDim.x; if (t < total) { const WTile w = wtile_of(P, t);
#pragma unroll
                for (int i = 0; i < 8; ++i) v[b][i] = w.src[(size_t)(ty + 8 * i) * w.ld_src + tx]; } }
#pragma unroll
        for (int b = 0; b < WB; ++b)
#pragma unroll
            for (int i = 0; i < 8; ++i) tile[b * WT + (ty + 8 * i) * 65 + tx] = v[b][i];
        __syncthreads();
#pragma unroll
        for (int b = 0; b < WB; ++b) { const int t = t0 + b * gridDim.x; if (t < total) { const WTile w = wtile_of(P, t);
#pragma unroll
                for (int i = 0; i < 8; ++i) w.dst[(size_t)(ty + 8 * i) * w.ld_dst + tx] = f2bf(tile[b * WT + tx * 65 + ty + 8 * i]); } }
        __syncthreads();
    }
}
#endif

constexpr int LDS_BYTES = pg8::STAGE_BYTES + 256;

#if DEV_CODE || !defined(HOST_TEST)
typedef const __attribute__((address_space(4))) Params* KParams;
__device__ __forceinline__ const Params* launder(KParams p) { asm volatile("" : "+s"(p)); return (const Params*)p; }
__global__ void __launch_bounds__(NTHREADS, 2) fwd_kernel(Params P_arg) {
    const KParams Pk = (KParams)__builtin_amdgcn_kernarg_segment_ptr();
    extern __shared__ __attribute__((aligned(16))) unsigned char lds[];
    const int tid = threadIdx.x;
    const int wbase_ = __builtin_amdgcn_readfirstlane(tid & ~63);
    volatile LAS unsigned* xbw = (volatile LAS unsigned*)((LAS unsigned char*)lds + pg8::STAGE_BYTES);
    if (tid < 4) xbw[tid] = 0u;
    __syncthreads();
    int pb, pe, n_chunks, depth;
    { const Params& P = *launder(Pk); pb = P.pb; pe = P.pe; n_chunks = P.cfg.n_chunks; depth = P.cfg.depth;
      if (pe - pb > 1) { XcdBarrier bar = xcd_barrier_post(P.ctl, xbw); xcd_barrier<true>(bar); } }
    int ctr = 0;
#ifndef STAGE_MASK
#define STAGE_MASK 0xFFFFFFFFu
#endif
#define STAGE_BEGIN(sid) if (((STAGE_MASK >> (sid)) & 1u) && ctr >= pb && ctr < pe) { const Params& P = *launder(Pk); const Cfg& cf = P.cfg; (void)cf; int tid_; asm volatile("v_mbcnt_lo_u32_b32 %0, -1, 0\n\tv_mbcnt_hi_u32_b32 %0, -1, %0\n\tv_add_u32 %0, %1, %0" : "=&v"(tid_) : "s"(wbase_)); const long gtid = (long)blockIdx.x * NTHREADS + tid_; const long gstride = (long)gridDim.x * NTHREADS; (void)gtid; (void)gstride;
#define STAGE_BEGIN_C(sid) STAGE_BEGIN(sid) const int T = cf.ck_nseq[ck] * cf.ck_L[ck]; (void)T;
#define STAGE_END   if (ctr + 1 < pe) { XcdBarrier bar_; bar_.bar = P.ctl; bar_.x = xb_xcc_id(); bar_.st = xbw; xcd_barrier<false>(bar_); } } ++ctr;
#define FOR_ITEMS(n, call) for (long it_ = gtid, n_ = (n); it_ < n_; it_ += gstride) { call; }

    STAGE_BEGIN(0)
        dev_prologue_weights(P, (LAS float*)lds, tid_);
        dev_quant_uv(P, tid_);
        FOR_ITEMS((long)cf.nseq_total * 1024, it_siluc(P, it_))
        FOR_ITEMS(cf.depth, it_lam(P, (int)it_))
        FOR_ITEMS((long)cf.depth * 2 * cf.Lmax * 64, it_hid1(P, it_))
        FOR_ITEMS((long)cf.depth * 16 * 128 * 128, it_keys_bf(P, it_))
        FOR_ITEMS((long)cf.depth * 16 * 1024, it_wdt(P, it_))
    STAGE_END
    STAGE_BEGIN(1)
        FOR_ITEMS((long)cf.depth * 2 * cf.Lmax * 64, it_hid2(P, it_))
        dev_ada(P, (LAS float*)lds, tid_);
        dev_quant_wrows(P, tid_);
    STAGE_END
    STAGE_BEGIN(2)
        dev_filt(P, tid_);
    STAGE_END
    STAGE_BEGIN(3)
        FOR_ITEMS((long)cf.depth * 2 * 64 * 1024, it_fsum(P, it_))
    STAGE_END
    STAGE_BEGIN(21)
        dev_gt(P, gtid, gstride);
    STAGE_END

    for (int ck = 0; ck < n_chunks; ++ck) {
        STAGE_BEGIN_C(4)
            dev_norm(P, ck, 0, 0, tid_);
        STAGE_END
        for (int l = 0; l < depth; ++l) {
            STAGE_BEGIN_C(5) {
                { pg8::Gemm g{P.H, P.wcat_t + (size_t)l * NCAT * DM, T, NPROJ, DM, DM, nullptr, nullptr}; pg8::StaticOrder S; S.init(T, NPROJ, gridDim.x, blockIdx.x);
                  pg8::EpiCat E{P.PROJ, (unsigned char*)P.GATES, P.in[IN_B_GATE] + (size_t)l * 4096, 0, nullptr, nullptr};
                  pg8::gemm_phase<pg8::EpiCat, pg8::StaticOrder, false>((PG8_LAS unsigned char*)lds, g, S, E, tid_); }
                { pg8::Gemm g{(const bf16_t*)P.HQ, (const bf16_t*)(P.WG8 + (size_t)l * 4096 * DM), T, 4096, DM / 2, DM / 2, P.HS, P.WGS + (size_t)l * 4096}; pg8::StaticOrder S; S.init(T, 4096, gridDim.x, blockIdx.x);
                  pg8::EpiCat E{P.PROJ, (unsigned char*)P.GATES, P.in[IN_B_GATE] + (size_t)l * 4096, 12, P.HS, P.WGS + (size_t)l * 4096};
                  pg8::gemm_phase<pg8::EpiCat, pg8::StaticOrder, true>((PG8_LAS unsigned char*)lds, g, S, E, tid_); }
                dev_dt(P, ck, l, tid_);
            } STAGE_END
            STAGE_BEGIN_C(6)
                dev_pre_tiles(P, ck, l, (LAS unsigned short*)lds, tid_);
                dev_scan_tiles(P, ck, l, (LAS unsigned short*)lds, tid_);
                FOR_ITEMS((long)T * 16, it_qknorm(P, l, it_))
                dev_cum(P, ck, l, tid_);
            STAGE_END
            STAGE_BEGIN_C(7)
                dev_scan_state<0>(P, ck, l, tid_);
                dev_scan_state<1>(P, ck, l, tid_);
                dev_attn(P, ck, l, (LAS unsigned char*)lds, tid_);
                dev_hyena(P, ck, l, 0, (LAS unsigned char*)lds, tid_);
            STAGE_END
            STAGE_BEGIN_C(8)
                FOR_ITEMS((long)2 * cf.ck_nseq[ck] * 4 * 32 * 64, it_scan_prefix(P, ck, 0, it_))
                FOR_ITEMS((long)2 * cf.ck_nseq[ck] * 4 * 64 * 64, it_scan_prefix(P, ck, 1, it_))
                dev_hyena(P, ck, l, 1, (LAS unsigned char*)lds, tid_);
            STAGE_END
            STAGE_BEGIN_C(18)
                dev_hyout_tiles(P, ck, (LAS unsigned short*)lds, tid_);
                dev_scan_out<0>(P, ck, l, tid_);
                dev_scan_out<1>(P, ck, l, tid_);
                __syncthreads();
                dev_scan_post(P, ck, l, tid_);
            STAGE_END
            STAGE_BEGIN_C(9) {
                pg8::Gemm g{P.YS, P.wbr_t + (size_t)l * 4096 * 256, T, 4096, 256, DM, nullptr, nullptr}; pg8::BranchOrder S; S.init(T, gridDim.x, blockIdx.x);
                pg8::EpiBranch E{P.MRG32, P.MRG, (const unsigned char*)P.GATES};
                pg8::gemm_phase((PG8_LAS unsigned char*)lds, g, S, E, tid_);
            } STAGE_END
            STAGE_BEGIN_C(10) {
                pg8::Gemm g{P.MRG, P.wout_t + (size_t)l * DM * DM, T, DM, DM, DM, nullptr, nullptr}; pg8::StaticOrder S; S.init(T, DM, gridDim.x, blockIdx.x);
                pg8::EpiOut E{l == 0 ? P.in[IN_X_PROMPT] : nullptr, l == 0 ? P.in[IN_X_SAMPLE] : nullptr, P.XB, P.ada + (size_t)l * cf.nseq_total * 6144, cf.ck_tok0[ck], cf.ck_seq0[ck], cf.ck_L[ck], cf.n_prompt_tok};
                pg8::gemm_phase((PG8_LAS unsigned char*)lds, g, S, E, tid_);
            } STAGE_END
            STAGE_BEGIN_C(11)
                dev_norm(P, ck, l, 1, tid_);
            STAGE_END
            STAGE_BEGIN_C(12) {
                pg8::Gemm g{(const bf16_t*)P.HQ, (const bf16_t*)(P.WQ8 + (size_t)l * 2048 * DM), T, 2048, DM / 2, DM / 2, P.HS, P.WQS + (size_t)l * 2048}; pg8::StaticOrder S; S.init(T, 2048, gridDim.x, blockIdx.x);
                pg8::EpiQ E{P.PROJ, P.in[IN_PEER_BQ] + (size_t)l * 2048, P.HS, P.WQS + (size_t)l * 2048};
                pg8::gemm_phase<pg8::EpiQ, pg8::StaticOrder, true>((PG8_LAS unsigned char*)lds, g, S, E, tid_);
                __syncthreads();
                dev_peer_topk(P, ck, l, tid_);
            } STAGE_END
            STAGE_BEGIN_C(15)
                dev_peer(P, ck, l, tid_);
            STAGE_END
        }
    }
}
#endif

static inline size_t al256(size_t x) { return (x + 255) & ~(size_t)255; }
static size_t build_params(Params& P, void* const* d_in, void* d_out, void* d_ws, int depth, int B1, int L1, int B2, int L2, int chunk_tok) {
    memset(&P, 0, sizeof(P));
    for (int i = 0; i < N_INPUTS; ++i) P.in[i] = (const float*)d_in[i];
    P.out = (float*)d_out;
    Cfg& c = P.cfg;
    c.depth = depth; c.nseq_total = B1 + B2; c.n_prompt_seq = B1; c.n_prompt_tok = B1 * L1; c.L_len[0] = L1; c.L_len[1] = L2; c.Lmax = L1 > L2 ? L1 : L2;
    int nc = 0, tmax = 0;
    { const int per = chunk_tok / L1 > 0 ? chunk_tok / L1 : 1; for (int s = 0; s < B1; s += per) { const int n = (B1 - s) < per ? (B1 - s) : per; c.ck_tok0[nc] = s * L1; c.ck_nseq[nc] = n; c.ck_L[nc] = L1; c.ck_seq0[nc] = s; c.ck_li[nc] = 0; if (n * L1 > tmax) tmax = n * L1; ++nc; } }
    { const int per = chunk_tok / L2 > 0 ? chunk_tok / L2 : 1; for (int s = 0; s < B2; s += per) { const int n = (B2 - s) < per ? (B2 - s) : per; c.ck_tok0[nc] = B1 * L1 + s * L2; c.ck_nseq[nc] = n; c.ck_L[nc] = L2; c.ck_seq0[nc] = B1 + s; c.ck_li[nc] = 1; if (n * L2 > tmax) tmax = n * L2; ++nc; } }
    c.n_chunks = nc; c.Tmax = tmax;
    unsigned char* ws = (unsigned char*)d_ws; size_t off = 0;
    auto take = [&](size_t bytes) { unsigned char* p = ws + off; off = al256(off + bytes); return p; };
    P.ctl = (unsigned*)take(65536);
    P.ada = (float*)take((size_t)depth * c.nseq_total * 6144 * 4);
    P.lam = (float*)take(256);
    P.hid1 = (float*)take((size_t)depth * 2 * c.Lmax * 64 * 4);
    P.hid2 = (float*)take((size_t)depth * 2 * c.Lmax * 64 * 4);
    P.filt = (float*)take((size_t)depth * (L1 + L2) * 1024 * 4);
    P.wcat_t = (bf16_t*)take((size_t)depth * NCAT * DM * 2);
    P.wbr_t = (bf16_t*)take((size_t)depth * 4096 * 256 * 2);
    P.wout_t = (bf16_t*)take((size_t)depth * DM * DM * 2);
    P.wq_t = (bf16_t*)take((size_t)depth * 2048 * DM * 2);
    const size_t T = tmax;
    P.H = (bf16_t*)take(T * DM * 2); P.PROJ = (bf16_t*)take(T * NPROJ * 2); P.GATES = (bf16_t*)take(T * 4096 * 2);
    P.HYU = nullptr; P.HYT = (bf16_t*)take(T * 768 * 2); P.VT = (bf16_t*)take(T * 256 * 2); P.GT = (bf16_t*)take((size_t)depth * 512 * (2 * (size_t)(L1 + L2) + 64) * 2); P.HYZ = (bf16_t*)take(T * 256 * 2); P.XBC = (bf16_t*)take(T * 512 * 2); P.YS = (bf16_t*)take(T * DM * 2); P.MRG = (bf16_t*)take(T * DM * 2);
    P.DT = (float*)take(T * 8 * 4); P.RETY = (float*)take(2 * T * 256 * 4); P.SSDY = (float*)take(2 * T * 256 * 4); P.ATTO = nullptr; P.XB = (bf16_t*)take(T * DM * 2); P.DT2 = (float*)take(T * 8 * 4);
    P.MRG32 = nullptr; P.PG = (float*)take(T * 128 * 4); P.PIDX = (int*)take(T * 128 * 4);
    P.CUM = (float*)take(16 * T * 4); P.DTS = (float*)take(8 * T * 4); P.CSR = (float*)take(2 * (T / SCK) * 4 * 32 * 64 * 4); P.CSS = (float*)take(2 * (T / SCK) * 4 * 64 * 64 * 4);
    P.HBR = (bf16_t*)take(2 * (T / SCK) * 4 * 32 * 64 * 2); P.HBS = (bf16_t*)take(2 * (T / SCK) * 4 * 64 * 64 * 2); P.RKT = (bf16_t*)take(T * 128 * 2); P.RVT = (bf16_t*)take(T * 256 * 2); P.XT = (bf16_t*)take(T * 384 * 2);
    P.fsum = (float*)take((size_t)depth * 2 * 64 * 1024 * 4); P.PU = (unsigned char*)take((size_t)depth * 16384 * 2048); P.PV = P.PU + 1024; P.PUs = (float*)take((size_t)depth * 16384 * 4); P.PVs = (float*)take((size_t)depth * 16384 * 4);
    P.keys_t = (float*)take((size_t)depth * 16 * 128 * 128 * 4); P.silu_c = (float*)take((size_t)c.nseq_total * DM * 4); P.keys_bf = (bf16_t*)take((size_t)depth * 16 * 128 * 128 * 2); P.WDT = (bf16_t*)take((size_t)depth * 16 * 1024 * 2);
    P.HQ = (signed char*)take(T * DM); P.HS = (float*)take(T * 4); P.WG8 = (signed char*)take((size_t)depth * 4096 * DM); P.WGS = (float*)take((size_t)depth * 4096 * 4); P.WQ8 = (signed char*)take((size_t)depth * 2048 * DM); P.WQS = (float*)take((size_t)depth * 2048 * 4);
    P.pb = 0; P.pe = 1 << 30;
    return off;
}

#ifndef HOST_TEST
#ifndef MK_MULTI_LAUNCH
#define MK_MULTI_LAUNCH 0
#endif
extern "C" void kernel_launch(void* const* d_in, const int* in_sizes, int n_in, void* d_out, int out_size, void* d_ws, size_t ws_size, hipStream_t stream) {
    static int grid = 0;
    Params P; const size_t need = build_params(P, d_in, d_out, d_ws, 4, 16, 4096, 8, 2048, 16384);
    if (grid == 0) {
        if (n_in != N_INPUTS || ws_size < need) { fprintf(stderr, "kernel_launch: n_in %d ws %zu need %zu\n", n_in, ws_size, need); grid = -1; return; }
        int dev = 0, cus = 0, per_cu = 0;
        if (hipGetDevice(&dev) != hipSuccess || hipDeviceGetAttribute(&cus, hipDeviceAttributeMultiprocessorCount, dev) != hipSuccess) { grid = -1; return; }
        if (hipFuncSetAttribute((const void*)fwd_kernel, hipFuncAttributeMaxDynamicSharedMemorySize, LDS_BYTES) != hipSuccess) { fprintf(stderr, "kernel_launch: hipFuncSetAttribute failed\n"); grid = -1; return; }
        if (hipOccupancyMaxActiveBlocksPerMultiprocessor(&per_cu, (const void*)fwd_kernel, NTHREADS, LDS_BYTES) != hipSuccess || per_cu < 1) fprintf(stderr, "kernel_launch: occupancy query says %d\n", per_cu);
        (void)hipGetLastError();
        grid = cus;
    }
    if (grid < 0) return;
    if (hipMemsetAsync(P.ctl, 0, 65536, stream) != hipSuccess) return;
#if MK_MULTI_LAUNCH
    const int n_stage = 5 + P.cfg.n_chunks * (1 + P.cfg.depth * 12);
    for (int s = 0; s < n_stage; ++s) { P.pb = s; P.pe = s + 1; hipLaunchKernelGGL(fwd_kernel, dim3(grid), dim3(NTHREADS), LDS_BYTES, stream, P); }
#else
    hipLaunchKernelGGL(fwd_kernel, dim3(grid), dim3(NTHREADS), LDS_BYTES, stream, P);
#endif
    const hipError_t le = hipPeekAtLastError();
    if (le != hipSuccess) fprintf(stderr, "kernel_launch: launch failed: %s\n", hipGetErrorName(le));
}
#endif
```

```cpp
#include <hip/hip_runtime.h>
#include <cstdio>
#include <cstdint>
#include <cstring>
#include <cmath>

#define HD __host__ __device__ __forceinline__
#if defined(__HIP_DEVICE_COMPILE__)
#define DEV_CODE 1
#else
#define DEV_CODE 0
#endif

typedef unsigned short bf16_t;
typedef float f32x4 __attribute__((ext_vector_type(4)));
typedef float f32x2 __attribute__((ext_vector_type(2)));
typedef unsigned u32x4 __attribute__((ext_vector_type(4)));
typedef unsigned u32x2 __attribute__((ext_vector_type(2)));
typedef short bf16x8 __attribute__((ext_vector_type(8)));

HD float u2f(unsigned u) { float f; memcpy(&f, &u, 4); return f; }
HD unsigned f2u(float f) { unsigned u; memcpy(&u, &f, 4); return u; }
HD float bf2f(bf16_t b) { return u2f(((unsigned)b) << 16); }
typedef __bf16 bf16x2_t __attribute__((ext_vector_type(2)));
HD bf16_t f2bf(float f) {
#if DEV_CODE
    const f32x2 v = {f, 0.f}; return (bf16_t)(__builtin_bit_cast(unsigned, __builtin_convertvector(v, bf16x2_t)) & 0xffffu);
#else
    unsigned u = f2u(f); if ((u & 0x7fffffffu) > 0x7f800000u) return (bf16_t)0x7fc0; u += 0x7fffu + ((u >> 16) & 1u); return (bf16_t)(u >> 16);
#endif
}
HD unsigned pack_bf16(float lo, float hi) {
#if DEV_CODE
    const f32x2 v = {lo, hi}; return __builtin_bit_cast(unsigned, __builtin_convertvector(v, bf16x2_t));
#else
    return (unsigned)f2bf(lo) | ((unsigned)f2bf(hi) << 16);
#endif
}
HD float fsinf(float x) {
#if DEV_CODE
    return __builtin_amdgcn_sinf(__builtin_amdgcn_fractf(x * 0.15915494309189535f));
#else
    return sinf(x);
#endif
}
HD float fcosf(float x) {
#if DEV_CODE
    return __builtin_amdgcn_cosf(__builtin_amdgcn_fractf(x * 0.15915494309189535f));
#else
    return cosf(x);
#endif
}
HD float fexpf(float x) {
#if DEV_CODE
    return __builtin_amdgcn_exp2f(x * 1.4426950408889634f);
#else
    return expf(x);
#endif
}
HD float siluf(float x) {
#if DEV_CODE
    return x * __builtin_amdgcn_rcpf(1.0f + __builtin_amdgcn_exp2f(x * -1.4426950408889634f));
#else
    return x / (1.0f + expf(-x));
#endif
}
HD float sigmoidf(float x) {
#if DEV_CODE
    return __builtin_amdgcn_rcpf(1.0f + __builtin_amdgcn_exp2f(x * -1.4426950408889634f));
#else
    return 1.0f / (1.0f + expf(-x));
#endif
}
HD float geluf(float x) { return 0.5f * x * (1.0f + erff(x * 0.70710678118654752f)); }
HD float gelu_as(float v) {
    const float av = fabsf(v), t = 1.0f / (av * 0.2316418882f + 1.0f);
    float q = t * 0.5307027145f - 0.7265760135f; q = q * t + 0.7107068705f; q = q * t - 0.142248368f; q = q * t + 0.127414796f; q = q * t;
    const float m = v * (q * exp2f(v * v * (-0.72134752044f)));
    return v < 0.f ? m : v - m;
}
HD float softplusf(float x) {
#if DEV_CODE
    return x > 20.f ? x : fmaxf(x, 0.f) + __builtin_amdgcn_logf(1.0f + __builtin_amdgcn_exp2f(-fabsf(x) * 1.4426950408889634f)) * 0.6931471805599453f;
#else
    return x > 20.f ? x : log1pf(expf(x));
#endif
}

constexpr int NTHREADS = 512, NTHREADS_ = 512;
constexpr int DM = 1024, NCAT = 7168, NPROJ = 3072, NIN = 3080;
enum { IN_X_PROMPT = 0, IN_X_SAMPLE, IN_C_PROMPT, IN_C_SAMPLE, IN_ADA_W, IN_ADA_B, IN_NORM1_W, IN_NORM2_W, IN_W_IN, IN_HY_CONV_W, IN_HY_CONV_B,
       IN_HF_W1, IN_HF_B1, IN_HF_W2, IN_HF_B2, IN_HF_W3, IN_HF_FREQ, IN_HY_BIAS, IN_DA_QNORM_W, IN_DA_KNORM_W, IN_DA_LQ1, IN_DA_LK1, IN_DA_LQ2, IN_DA_LK2,
       IN_DA_SUBLN_W, IN_RET_GN_W, IN_SSM_CONV_W, IN_SSM_CONV_B, IN_SSM_DT_BIAS, IN_SSM_A_LOG, IN_SSM_D, IN_SSM_NORM_W, IN_W_BRANCH, IN_W_GATE, IN_B_GATE,
       IN_W_OUT, IN_PEER_WQ, IN_PEER_BQ, IN_PEER_KEYS, IN_PEER_U, IN_PEER_V, N_INPUTS };
constexpr int C_HY = 0, C_DAQ = 768, C_DAK = 1024, C_DAV = 1280, C_RQ = 1536, C_RK = 1664, C_RV = 1792, C_RG = 2048, C_SZ = 2304, C_SXBC = 2560;

struct Cfg {
    int depth, n_chunks, nseq_total, n_prompt_seq, n_prompt_tok, Tmax, Lmax, pad0;
    int ck_tok0[8], ck_nseq[8], ck_L[8], ck_seq0[8], ck_li[8];
    int L_len[2];
};
struct Params {
    const float* in[N_INPUTS];
    float* out;
    unsigned* ctl;
    float *ada, *lam, *hid1, *hid2, *filt;
    bf16_t *wcat_t, *wbr_t, *wout_t, *wq_t;
    bf16_t *H, *PROJ, *GATES, *HYU, *HYZ, *XBC, *YS, *MRG;
    float *DT, *RETY, *SSDY, *ATTO, *MRG32, *PG;
    float* DT2;
    bf16_t* XB;
    float *CUM, *DTS, *CSR, *CSS, *keys_t, *fsum, *silu_c;
    bf16_t *HBR, *HBS, *RKT, *RVT, *XT, *keys_bf, *WDT;
    signed char *HQ, *WG8, *WQ8; float *HS, *WGS, *WQS;
    bf16_t *GT, *HYT, *VT;
    unsigned char *PU, *PV; float *PUs, *PVs;
    int* PIDX;
    Cfg cfg;
    int pb, pe;
};

HD const float* x_row_in(const Params& P, int tok) {
    return tok < P.cfg.n_prompt_tok ? P.in[IN_X_PROMPT] + (size_t)tok * DM : P.in[IN_X_SAMPLE] + (size_t)(tok - P.cfg.n_prompt_tok) * DM;
}
HD const float* c_row(const Params& P, int s) {
    return s < P.cfg.n_prompt_seq ? P.in[IN_C_PROMPT] + (size_t)s * DM : P.in[IN_C_SAMPLE] + (size_t)(s - P.cfg.n_prompt_seq) * DM;
}
HD size_t filt_base(const Params& P, int l, int li) { return ((size_t)l * (P.cfg.L_len[0] + P.cfg.L_len[1]) + (li ? P.cfg.L_len[0] : 0)) * 1024; }
HD const float* ada_row(const Params& P, int l, int s) { return P.ada + ((size_t)l * P.cfg.nseq_total + s) * 6144; }

HD void it_wcat(const Params& P, long idx) {
    const int k = idx % DM, n = (idx / DM) % NCAT, l = idx / ((long)DM * NCAT);
    float v;
    if (n < NPROJ) v = P.in[IN_W_IN][((size_t)l * DM + k) * NIN + n];
    else { const int i = (n - NPROJ) >> 10, nn = (n - NPROJ) & 1023; v = P.in[IN_W_GATE][(((size_t)l * 4 + i) * DM + k) * DM + nn]; }
    P.wcat_t[idx] = f2bf(v);
}
HD void it_wbr(const Params& P, long idx) {
    const int k = idx % 256, row = (idx / 256) % 4096, l = idx / (256 * 4096); const int i = row >> 10, n = row & 1023;
    P.wbr_t[idx] = f2bf(P.in[IN_W_BRANCH][(((size_t)l * 4 + i) * 256 + k) * DM + n]);
}
HD void it_wout(const Params& P, long idx) {
    const int k = idx % DM, n = (idx / DM) % DM, l = idx / ((long)DM * DM);
    P.wout_t[idx] = f2bf(P.in[IN_W_OUT][((size_t)l * DM + k) * DM + n]);
}
HD void it_wq(const Params& P, long idx) {
    const int k = idx % DM, n = (idx / DM) % 2048, l = idx / ((long)DM * 2048);
    P.wq_t[idx] = f2bf(P.in[IN_PEER_WQ][((size_t)l * DM + k) * 2048 + n]);
}
HD void it_siluc(const Params& P, long idx) { const int k = idx & 1023, sq = idx >> 10; P.silu_c[idx] = siluf(c_row(P, sq)[k]); }
HD void it_ada(const Params& P, long idx) {
    const int j = idx % 6144, sq = (idx / 6144) % P.cfg.nseq_total, l = idx / (6144 * (long)P.cfg.nseq_total);
    const float* c = P.silu_c + (size_t)sq * DM; const float* w = P.in[IN_ADA_W] + (size_t)l * DM * 6144 + j;
    float acc = 0.f;
    for (int k = 0; k < DM; k += 8) { float wv[8];
#pragma unroll
        for (int e = 0; e < 8; ++e) wv[e] = w[(size_t)(k + e) * 6144];
#pragma unroll
        for (int e = 0; e < 8; ++e) acc += c[k + e] * wv[e]; }
    P.ada[idx] = acc + P.in[IN_ADA_B][l * 6144 + j];
}
HD void it_lam(const Params& P, int l) {
    float s1 = 0.f, s2 = 0.f, mq = 0.f, mk = 0.f;
    for (int d = 0; d < 32; ++d) {
        s1 += P.in[IN_DA_LQ1][l * 32 + d] * P.in[IN_DA_LK1][l * 32 + d]; s2 += P.in[IN_DA_LQ2][l * 32 + d] * P.in[IN_DA_LK2][l * 32 + d];
        mq = fmaxf(mq, fabsf(P.in[IN_DA_QNORM_W][l * 32 + d])); mk = fmaxf(mk, fabsf(P.in[IN_DA_KNORM_W][l * 32 + d]));
    }
    const float lam_init = 0.8f - 0.6f * expf(-0.3f * (float)l);
    P.lam[l * 4 + 0] = expf(s1) - expf(s2) + lam_init; P.lam[l * 4 + 1] = lam_init; P.lam[l * 4 + 2] = 5.656854249f * mq * mk; P.lam[l * 4 + 3] = 0.f;
}
HD void it_hid1(const Params& P, long idx) {
    const int j = idx & 63; const int pos = (idx >> 6) % P.cfg.Lmax; const int li = ((idx >> 6) / P.cfg.Lmax) & 1; const int l = (idx >> 6) / P.cfg.Lmax / 2;
    const int L = P.cfg.L_len[li]; if (pos >= L) return;
    const float* w1 = P.in[IN_HF_W1] + (size_t)l * 33 * 64 + j;
    const float t = (float)pos / (float)(L - 1);
    float acc = t * w1[0];
    const float w0 = 2.0f * 3.14159265358979323846f / (float)L;
    for (int b = 0; b < 16; ++b) {
        const float band = 1e-4f + (float)b * ((15.0f - 1e-4f) / 15.0f);
        const float ang = w0 * (float)pos * band;
        acc += fcosf(ang) * w1[(1 + b) * 64] - fsinf(ang) * w1[(17 + b) * 64];
    }
    P.hid1[idx] = fsinf(P.in[IN_HF_FREQ][l * 64 + j] * (acc + P.in[IN_HF_B1][l * 64 + j]));
}
HD void it_hid2(const Params& P, long idx) {
    const int j = idx & 63; const int pos = (idx >> 6) % P.cfg.Lmax; const int li = ((idx >> 6) / P.cfg.Lmax) & 1; const int l = (idx >> 6) / P.cfg.Lmax / 2;
    if (pos >= P.cfg.L_len[li]) return;
    const float* h1 = P.hid1 + (idx & ~63L); const float* w2 = P.in[IN_HF_W2] + (size_t)l * 64 * 64 + j;
    float acc = 0.f;
    for (int i = 0; i < 64; ++i) acc += h1[i] * w2[i * 64];
    P.hid2[idx] = fsinf(P.in[IN_HF_FREQ][l * 64 + j] * (acc + P.in[IN_HF_B2][l * 64 + j]));
}
HD void it_filt(const Params& P, long idx) {
    const int c4 = idx & 255; const long pr = idx >> 8; const int pos = pr % P.cfg.Lmax; const int li = (pr / P.cfg.Lmax) & 1; const int l = pr / P.cfg.Lmax / 2;
    const int L = P.cfg.L_len[li]; if (pos >= L) return;
    const float* h2 = P.hid2 + pr * 64; const float* w3 = P.in[IN_HF_W3] + (size_t)l * 64 * 1024 + c4 * 4;
    f32x4 acc = {0.f, 0.f, 0.f, 0.f};
    for (int j = 0; j < 64; ++j) acc += *(const f32x4*)(w3 + j * 1024) * h2[j];
    const float t = (float)pos / (float)(L - 1);
    const float mn = -3.0701134573253945f, mx = -15.350567286626972f;
    f32x4 o;
#pragma unroll
    for (int e = 0; e < 4; ++e) { const float delta = fabsf(mn + (float)((c4 * 4 + e) & 255) * ((mx - mn) / 255.0f)); o[e] = acc[e] * expf(-t * delta); }
    *(f32x4*)(P.filt + filt_base(P, l, li) + (size_t)pos * 1024 + c4 * 4) = o;
}
HD void it_fsum(const Params& P, long idx) {
    const int col = idx & 1023, chunk = (idx >> 10) & 63; const int lli = idx >> 16; const int L = P.cfg.L_len[lli & 1], per = L / 64;
    const float* f = P.filt + filt_base(P, lli >> 1, lli & 1) + (size_t)chunk * per * 1024 + col;
    float ss = 0.f;
#pragma unroll 16
    for (int p = 0; p < per; ++p) { const float v = f[(size_t)p * 1024]; ss += v * v; }
    P.fsum[idx] = ss;
}
HD void it_quant_uv(const Params& P, long idx) {
    const long nrow = (long)P.cfg.depth * 16384; const bool isv = idx >= nrow; const long r = isv ? idx - nrow : idx;
    const float* src = P.in[isv ? IN_PEER_V : IN_PEER_U] + r * DM; unsigned char* dst = P.PU + r * 2048 + (isv ? 1024 : 0);
    float amax = 0.f; for (int i = 0; i < DM; ++i) amax = fmaxf(amax, fabsf(src[i]));
    const float sc = amax > 0.f ? amax * (1.0f / 127.0f) : 1.0f, inv = 1.0f / sc;
    for (int i = 0; i < DM; ++i) dst[i] = (unsigned char)(signed char)(int)rintf(src[i] * inv);
    (isv ? P.PVs : P.PUs)[r] = sc;
}

HD void it_norm(const Params& P, int ck, int l, int which, int tl) {
    const int tok = P.cfg.ck_tok0[ck] + tl, s = P.cfg.ck_seq0[ck] + tl / P.cfg.ck_L[ck];
    const float* x = (which == 0 && l == 0) ? x_row_in(P, tok) : P.out + (size_t)tok * DM;
    const float* ad = ada_row(P, l, s) + (which ? 3072 : 0);
    const float* nw = P.in[which ? IN_NORM2_W : IN_NORM1_W] + l * DM;
    float ss = 0.f;
    for (int k = 0; k < DM; ++k) ss += x[k] * x[k];
    const float r = 1.0f / sqrtf(ss * (1.0f / DM) + 1e-6f);
    float dt[8] = {0.f, 0.f, 0.f, 0.f, 0.f, 0.f, 0.f, 0.f};
    const float* wdt = P.in[IN_W_IN] + (size_t)l * DM * NIN + NPROJ;
    bf16_t* h = P.H + (size_t)tl * DM;
    for (int k = 0; k < DM; ++k) {
        const float hv = x[k] * r * nw[k] * (1.0f + ad[1024 + k]) + ad[k];
        h[k] = f2bf(hv);
        if (which == 0) {
#pragma unroll
            for (int j = 0; j < 8; ++j) dt[j] += hv * wdt[(size_t)k * NIN + j];
        }
    }
    if (which == 0) {
#pragma unroll
        for (int j = 0; j < 8; ++j) P.DT[(size_t)tl * 8 + j] = dt[j];
    }
}

HD void it_hyconv(const Params& P, int ck, int l, long idx) {
    const int c = idx % 768; const int tl = idx / 768; const int L = P.cfg.ck_L[ck], t = tl % L, sl = tl / L;
    const float* w = P.in[IN_HY_CONV_W] + (size_t)l * 3 * 768 + c;
    float acc = P.in[IN_HY_CONV_B][l * 768 + c];
#pragma unroll
    for (int j = 0; j < 3; ++j) { const int tt = t + j - 1; if (tt >= 0 && tt < L) acc += w[j * 768] * bf2f(P.PROJ[(size_t)(tl + j - 1) * NPROJ + C_HY + c]); }
    P.HYT[((size_t)sl * 768 + c) * L + t] = f2bf(acc);
}
HD void it_vt(const Params& P, int ck, long idx) {
    const int c = idx & 255; const int tl = idx >> 8; const int L = P.cfg.ck_L[ck];
    P.VT[((size_t)(tl / L) * 256 + c) * L + (tl % L)] = P.PROJ[(size_t)tl * NPROJ + C_DAV + c];
}
HD void it_hyout(const Params& P, int ck, long idx) {
    const int c = idx & 255; const int tl = idx >> 8; const int L = P.cfg.ck_L[ck];
    P.YS[(size_t)tl * DM + c] = P.HYT[((size_t)(tl / L) * 768 + c) * L + (tl % L)];
}
HD void it_xbc(const Params& P, int ck, int l, long idx) {
    const int c = idx & 511; const int tl = idx >> 9; const int L = P.cfg.ck_L[ck], t = tl % L;
    const float* w = P.in[IN_SSM_CONV_W] + (size_t)l * 5 * 512 + c;
    float acc = P.in[IN_SSM_CONV_B][l * 512 + c];
#pragma unroll
    for (int j = 0; j < 5; ++j) { const int tt = t + j - 2; if (tt >= 0 && tt < L) acc += w[j * 512] * bf2f(P.PROJ[(size_t)(tl + j - 2) * NPROJ + C_SXBC + c]); }
    P.XBC[idx] = f2bf(siluf(acc));
}
HD void it_qknorm(const Params& P, int l, long idx) {
    const int sub = idx & 15; const int tl = idx >> 4; const int which = sub >> 3, hc = sub & 7;
    bf16_t* p = P.PROJ + (size_t)tl * NPROJ + (which ? C_DAK : C_DAQ) + hc * 32;
    const float* w = P.in[which ? IN_DA_KNORM_W : IN_DA_QNORM_W] + l * 32;
    u32x4 raw[4]; float v[32]; float ss = 0.f;
#pragma unroll
    for (int i = 0; i < 4; ++i) raw[i] = *(const u32x4*)(p + 8 * i);
#pragma unroll
    for (int i = 0; i < 4; ++i) { const unsigned ww[4] = {raw[i].x, raw[i].y, raw[i].z, raw[i].w};
#pragma unroll
        for (int e = 0; e < 4; ++e) { v[8 * i + 2 * e] = u2f(ww[e] << 16); v[8 * i + 2 * e + 1] = u2f(ww[e] & 0xffff0000u); } }
#pragma unroll
    for (int d = 0; d < 32; ++d) ss += v[d] * v[d];
#if DEV_CODE
    const float r = (1.0f / sqrtf(ss * (1.0f / 32.0f) + 1e-6f)) * (which ? 1.0f : 0.17677669529663687f * 1.4426950408889634f);
#else
    const float r = (1.0f / sqrtf(ss * (1.0f / 32.0f) + 1e-6f)) * (which ? 1.0f : 0.17677669529663687f);
#endif
#pragma unroll
    for (int i = 0; i < 4; ++i) { u32x4 o; o.x = pack_bf16(v[8 * i] * r * w[8 * i], v[8 * i + 1] * r * w[8 * i + 1]); o.y = pack_bf16(v[8 * i + 2] * r * w[8 * i + 2], v[8 * i + 3] * r * w[8 * i + 3]);
        o.z = pack_bf16(v[8 * i + 4] * r * w[8 * i + 4], v[8 * i + 5] * r * w[8 * i + 5]); o.w = pack_bf16(v[8 * i + 6] * r * w[8 * i + 6], v[8 * i + 7] * r * w[8 * i + 7]);
        *(u32x4*)(p + 8 * i) = o; }
}

constexpr int SCK = 64;
HD float ret_la(int dir, int head) {
#if DEV_CODE
    const float e = __builtin_amdgcn_exp2f(-(dir ? 5.5f : 5.0f) - (float)head);
    return -e * (1.0f + e * (0.5f + e * (0.33333333f + e * (0.25f + e * (0.2f + e * 0.16666667f)))));
#else
    return log1pf(-exp2f(-(dir ? 5.5f : 5.0f) - (float)head));
#endif
}
HD size_t cum_idx(const Params& P, int ty, int d, int sl, int h, int t, int L) { return ((size_t)(ty * 2 + d) * 4 * P.cfg.Tmax) + (size_t)(sl * 4 + h) * L + t; }
HD void it_cum(const Params& P, int ck, int l, long idx) {
    const int L = P.cfg.ck_L[ck], nchunk = L / SCK, nseq = P.cfg.ck_nseq[ck];
    const int h = idx & 3; const int c = (idx >> 2) % nchunk; const int sl = ((idx >> 2) / nchunk) % nseq; const int d = ((idx >> 2) / nchunk / nseq) & 1; const int ty = (idx >> 2) / nchunk / nseq / 2;
    float* cum = P.CUM + cum_idx(P, ty, d, sl, h, c * SCK, L);
    if (ty == 0) { const float la = ret_la(d, h); for (int jj = 0; jj < SCK; ++jj) cum[jj] = (float)(d ? SCK - jj : jj + 1) * la; return; }
    const float A = -expf(P.in[IN_SSM_A_LOG][l * 8 + d * 4 + h]); const float dtb = P.in[IN_SSM_DT_BIAS][l * 8 + d * 4 + h];
    float* dts = P.DTS + cum_idx(P, 0, d, sl, h, c * SCK, L); float run = 0.f;
    for (int k = 0; k < SCK; ++k) { const int jj = d ? SCK - 1 - k : k; const size_t tl = (size_t)sl * L + c * SCK + jj;
        const float dt = softplusf(P.DT[tl * 8 + d * 4 + h] + dtb); run += dt * A; cum[jj] = run; dts[jj] = dt; }
}
HD void it_scan_tr(const Params& P, int ck, long idx) {
    const int c = idx % 768; const int tl = idx / 768; const int L = P.cfg.ck_L[ck], sl = tl / L, t = tl % L;
    if (c < 128) P.RKT[((size_t)sl * 128 + c) * L + t] = P.PROJ[(size_t)tl * NPROJ + C_RK + c];
    else if (c < 384) P.RVT[((size_t)sl * 256 + (c - 128)) * L + t] = P.PROJ[(size_t)tl * NPROJ + C_RV + (c - 128)];
    else P.XT[((size_t)sl * 384 + (c - 384)) * L + t] = P.XBC[(size_t)tl * 512 + (c - 384)];
}
HD const bf16_t* sc_qrow(const Params& P, int ty, int h, size_t tl) { return ty ? P.XBC + tl * 512 + 384 + (h >> 1) * 64 : P.PROJ + tl * NPROJ + C_RQ + h * 32; }
HD const bf16_t* sc_krow(const Params& P, int ty, int h, size_t tl) { return ty ? P.XBC + tl * 512 + 256 + (h >> 1) * 64 : P.PROJ + tl * NPROJ + C_RK + h * 32; }
HD const bf16_t* sc_kT(const Params& P, int ty, int sl, int h, int n, int L) { return ty ? P.XT + ((size_t)sl * 384 + 256 + (h >> 1) * 64 + n) * L : P.RKT + ((size_t)sl * 128 + h * 32 + n) * L; }
HD const bf16_t* sc_vT(const Params& P, int ty, int sl, int h, int p, int L) { return ty ? P.XT + ((size_t)sl * 384 + h * 64 + p) * L : P.RVT + ((size_t)sl * 256 + h * 64 + p) * L; }
HD size_t sc_unit(int d, int sl, int c, int h, int nseq, int nchunk) { return (((size_t)(d * nseq + sl) * nchunk + c) * 4 + h); }
template <int G> HD void scan_prefix_g(const Params& P, int ck, int ty, long idx) {
    const int L = P.cfg.ck_L[ck], nchunk = L / SCK, nseq = P.cfg.ck_nseq[ck]; const int N = ty ? 64 : 32;
    const int pn = idx & (N * 64 - 1); const long r = idx >> (ty ? 12 : 11); const int h = r & 3; const int sl = (r >> 2) % nseq; const int d = (r >> 2) / nseq;
    const float* cs = (ty ? P.CSS : P.CSR); bf16_t* hb = (ty ? P.HBS : P.HBR); float H = 0.f;
    for (int k0 = 0; k0 < nchunk; k0 += G) {
        float cv[G], dc[G];
#pragma unroll
        for (int j = 0; j < G; ++j) { const int c = d ? nchunk - 1 - (k0 + j) : k0 + j;
            cv[j] = cs[sc_unit(d, sl, c, h, nseq, nchunk) * (N * 64) + pn]; dc[j] = P.CUM[cum_idx(P, ty, d, sl, h, c * SCK + (d ? 0 : SCK - 1), L)]; }
#pragma unroll
        for (int j = 0; j < G; ++j) { const int c = d ? nchunk - 1 - (k0 + j) : k0 + j; hb[sc_unit(d, sl, c, h, nseq, nchunk) * (N * 64) + pn] = f2bf(H); H = H * fexpf(dc[j]) + cv[j]; }
    }
}
HD void it_scan_prefix(const Params& P, int ck, int ty, long idx) {
    if ((P.cfg.ck_L[ck] / SCK) % 16 == 0) scan_prefix_g<16>(P, ck, ty, idx); else scan_prefix_g<4>(P, ck, ty, idx);
}

HD void it_attn(const Params& P, int ck, int l, long idx) {
    const int L = P.cfg.ck_L[ck]; const int t = idx % L; const int r = idx / L; const int vh = r & 1, head = (r >> 1) & 3, sl = r >> 3;
    const float lam = P.lam[l * 4 + 0], M = P.lam[l * 4 + 2]; const float slope = exp2f(-2.0f * (float)(head + 1));
    const size_t tl = (size_t)sl * L + t;
    float q1[32], q2[32], o1[32], o2[32];
    { const bf16_t* qp = P.PROJ + tl * NPROJ + C_DAQ + head * 64;
#pragma unroll
      for (int d = 0; d < 32; ++d) { q1[d] = bf2f(qp[d]); q2[d] = bf2f(qp[32 + d]); o1[d] = 0.f; o2[d] = 0.f; } }
    float l1 = 0.f, l2 = 0.f;
    for (int j = 0; j < L; ++j) {
        const bf16_t* kr = P.PROJ + ((size_t)sl * L + j) * NPROJ;
        const bf16_t* kp = kr + C_DAK + head * 64; const bf16_t* vp = kr + C_DAV + head * 64 + vh * 32;
        float s1 = 0.f, s2 = 0.f;
#pragma unroll
        for (int d = 0; d < 32; ++d) { s1 += q1[d] * bf2f(kp[d]); s2 += q2[d] * bf2f(kp[32 + d]); }
        const float bias = -slope * fabsf((float)(t - j)) - M;
        const float e1 = expf(s1 + bias), e2 = expf(s2 + bias);
        l1 += e1; l2 += e2;
#pragma unroll
        for (int d = 0; d < 32; ++d) { const float v = bf2f(vp[d]); o1[d] += e1 * v; o2[d] += e2 * v; }
    }
    const float r1 = 1.0f / l1, r2 = lam / l2;
    float* o = P.ATTO + tl * 256 + head * 64 + vh * 32;
#pragma unroll
    for (int d = 0; d < 32; ++d) o[d] = o1[d] * r1 - o2[d] * r2;
}

HD size_t gt_base(const Params& P, int l, int li, int oc) { const size_t x0 = 2 * (size_t)P.cfg.L_len[0] + 32, x1 = 2 * (size_t)P.cfg.L_len[1] + 32; return ((size_t)l * 512 + oc) * (x0 + x1) + (li ? x0 : 0); }
HD void it_gt(const Params& P, long idx) {
    const int NGX = (2 * P.cfg.Lmax + 32) / 16; const int oc = idx & 511; const long r = idx >> 9; const int xg = r % NGX; const int li = (r / NGX) & 1, l = r / NGX / 2;
    const int L = P.cfg.L_len[li]; const int x0 = xg * 16; if (x0 >= 2 * L + 32) return;
    const int o = oc >> 8, c = oc & 255; const int d0 = L + 15 - x0;
    const bool fwd = d0 >= 15; const int col = o * 512 + (fwd ? 0 : 256) + c;
    const float* fs = P.fsum + (size_t)(l * 2 + li) * 65536 + col; float ss = 0.f;
    for (int k = 0; k < 64; ++k) ss += fs[k * 1024];
    const float sc = 1.0f / sqrtf(ss + 1e-6f); const float* f = P.filt + filt_base(P, l, li) + col;
    float v[16];
#pragma unroll
    for (int j = 0; j < 16; ++j) { const int d = d0 - j; const int ad = d >= 0 ? d : -d; v[j] = ad < L ? f[(size_t)ad * 1024] * sc : 0.f; }
    u32x4 w0, w1;
    w0.x = pack_bf16(v[0], v[1]); w0.y = pack_bf16(v[2], v[3]); w0.z = pack_bf16(v[4], v[5]); w0.w = pack_bf16(v[6], v[7]);
    w1.x = pack_bf16(v[8], v[9]); w1.y = pack_bf16(v[10], v[11]); w1.z = pack_bf16(v[12], v[13]); w1.w = pack_bf16(v[14], v[15]);
    bf16_t* dst = P.GT + gt_base(P, l, li, oc) + x0; *(u32x4*)dst = w0; *(u32x4*)(dst + 8) = w1;
}
HD int hy_afrag_x0(int L, int m, int lane) { const int i = lane & 15, q = lane >> 4; return L + 15 - (16 * (2 * m + (q >> 1)) + i - 8 * (q & 1)); }
HD int hy_bfrag_pos(int ct, int m, int lane) { const int col = lane & 15, q = lane >> 4; return 256 * ct + 16 * col - 32 * m - 16 * (q >> 1) + 8 * (q & 1); }
HD void hy_mrange(int L, int ct, int& m_lo, int& m_hi) { const int lo = 16 * ct - (L / 16 - 1), hi = 16 * ct + 15; m_lo = (lo >= 0 ? lo : lo - 1) / 2; m_hi = hi / 2; }
constexpr int HY_PAD = 256;

HD void it_attnpost(const Params& P, int l, long idx) {
    const int head = idx & 3; const size_t tl = idx >> 2; const float* o = P.ATTO + tl * 256 + head * 64;
    float ss = 0.f;
    for (int d = 0; d < 64; ++d) ss += o[d] * o[d];
    const float r = (1.0f / sqrtf(ss * (1.0f / 64.0f) + 1e-6f)) * (1.0f - P.lam[l * 4 + 1]);
    const float* w = P.in[IN_DA_SUBLN_W] + l * 256 + head * 64;
    for (int d = 0; d < 64; ++d) P.YS[tl * DM + 256 + head * 64 + d] = f2bf(o[d] * r * w[d]);
}
HD void it_retpost(const Params& P, int l, long idx) {
    const int head = idx & 3; const size_t tl = idx >> 2;
    const float* y0 = P.RETY + tl * 256 + head * 64; const float* y1 = y0 + (size_t)P.cfg.Tmax * 256;
    float ss = 0.f;
    for (int d = 0; d < 64; ++d) { const float y = y0[d] + y1[d]; ss += y * y; }
    const float r = 1.0f / sqrtf(ss * (1.0f / 64.0f) + 1e-6f);
    const float* w = P.in[IN_RET_GN_W] + l * 256 + head * 64; const bf16_t* g = P.PROJ + tl * NPROJ + C_RG + head * 64;
    for (int d = 0; d < 64; ++d) P.YS[tl * DM + 512 + head * 64 + d] = f2bf((y0[d] + y1[d]) * r * w[d] * siluf(bf2f(g[d])));
}
HD void it_ssdpost(const Params& P, int l, long idx) {
    const size_t tl = idx; const float* y0 = P.SSDY + tl * 256; const float* y1 = y0 + (size_t)P.cfg.Tmax * 256;
    const bf16_t* xs = P.XBC + tl * 512; const bf16_t* z = P.PROJ + tl * NPROJ + C_SZ; const float* Dp = P.in[IN_SSM_D] + l * 4;
    float ss = 0.f;
    for (int c = 0; c < 256; ++c) { const float y = (y0[c] + y1[c] + Dp[c >> 6] * bf2f(xs[c])) * siluf(bf2f(z[c])); ss += y * y; }
    const float r = 1.0f / sqrtf(ss * (1.0f / 256.0f) + 1e-6f); const float* w = P.in[IN_SSM_NORM_W] + l * 256;
    for (int c = 0; c < 256; ++c) { const float y = (y0[c] + y1[c] + Dp[c >> 6] * bf2f(xs[c])) * siluf(bf2f(z[c])); P.YS[tl * DM + 768 + c] = f2bf(y * r * w[c]); }
}

HD void it_keys_t(const Params& P, long idx) {
    const int key = idx & 127, d = (idx >> 7) & 127; const long lh = idx >> 14;
    P.keys_t[idx] = P.in[IN_PEER_KEYS][(lh * 128 + key) * 128 + d];
}
HD void it_wdt(const Params& P, long idx) {
    const int k = idx & 1023, j = (idx >> 10) & 15, l = idx >> 14; P.WDT[idx] = j < 8 ? f2bf(P.in[IN_W_IN][((size_t)l * DM + k) * NIN + NPROJ + j]) : (bf16_t)0;
}
HD void it_keys_bf(const Params& P, long idx) { P.keys_bf[idx] = f2bf(P.in[IN_PEER_KEYS][idx]); }
HD void it_pscore(const Params& P, int l, long idx) {
    const int k4 = idx & 31, hc = (idx >> 5) & 15; const size_t tl = idx >> 9;
    const bf16_t* q = P.PROJ + tl * 2048 + hc * 128; const float* kt = P.keys_t + (((size_t)l * 16 + hc) * 128) * 128 + k4 * 4;
    f32x4 acc = {0.f, 0.f, 0.f, 0.f};
    for (int d = 0; d < 128; ++d) acc += *(const f32x4*)(kt + d * 128) * bf2f(q[d]);
    *(f32x4*)((float*)P.GATES + tl * 2048 + hc * 128 + k4 * 4) = acc;
}
#define TOPK_INSERT(v, ix, x, xi) do { _Pragma("unroll") for (int _k = 15; _k >= 1; --_k) { const bool gp = (x) > v[_k - 1], gc = (x) > v[_k]; \
        v[_k] = gp ? v[_k - 1] : (gc ? (x) : v[_k]); ix[_k] = gp ? ix[_k - 1] : (gc ? (xi) : ix[_k]); } \
        { const bool g0 = (x) > v[0]; v[0] = g0 ? (x) : v[0]; ix[0] = g0 ? (xi) : ix[0]; } } while (0)
HD void it_ptopk(const Params& P, long idx) {
    const int h = idx & 7; const size_t tl = idx >> 3;
    const float* s = (const float*)P.GATES + tl * 2048 + h * 256;
    float v1[16], v2[16], vt[16]; int i1[16], i2[16], it[16];
#pragma unroll
    for (int k = 0; k < 16; ++k) { v1[k] = -3.0e38f; v2[k] = -3.0e38f; vt[k] = -3.0e38f; i1[k] = 0; i2[k] = 0; it[k] = 0; }
    for (int k = 0; k < 128; ++k) { const float x = s[k]; TOPK_INSERT(v1, i1, x, k); }
    for (int k = 0; k < 128; ++k) { const float x = s[128 + k]; TOPK_INSERT(v2, i2, x, k); }
#pragma unroll
    for (int a = 0; a < 16; ++a) {
#pragma unroll
        for (int b = 0; b < 16; ++b) { const float x = v1[a] + v2[b]; const int xi = i1[a] * 128 + i2[b]; TOPK_INSERT(vt, it, x, xi); }
    }
    float den = 0.f, e[16];
#pragma unroll
    for (int k = 0; k < 16; ++k) { e[k] = expf(vt[k] - vt[0]); den += e[k]; }
    const float rd = 1.0f / den;
#pragma unroll
    for (int k = 0; k < 16; ++k) { P.PIDX[tl * 128 + h * 16 + k] = it[k]; P.PG[tl * 128 + h * 16 + k] = e[k] * rd; }
}
HD void it_peer_a(const Params& P, int l, long idx) {
    const int part = idx & 15; const size_t te = idx >> 4; const size_t tl = te >> 7;
    const int ex = P.PIDX[te]; const signed char* u = (const signed char*)P.PU + ((size_t)l * 16384 + ex) * 2048 + part * 4; const bf16_t* hrow = P.H + tl * DM; const float sc = P.PUs[(size_t)l * 16384 + ex];
    float hmax = 0.f; for (int i = 0; i < DM; ++i) hmax = fmaxf(hmax, fabsf(bf2f(hrow[i])));
    const float hinv = hmax > 0.f ? 127.0f / hmax : 0.f; const bf16_t* h = hrow + part * 4;
    int acc = 0;
    for (int i = 0; i < 16; ++i) { const signed char* up = u + 64 * i; const bf16_t* hp = h + 64 * i;
        for (int j = 0; j < 4; ++j) acc += (int)rintf(bf2f(hp[j]) * hinv) * (int)up[j]; }
    ((float*)P.GATES)[idx] = (float)acc * sc * (hmax * (1.0f / 127.0f));
}
HD void it_peer_b0(const Params& P, long idx) {
    const float* pp = (const float*)P.GATES + idx * 16; float s = 0.f;
#pragma unroll
    for (int i = 0; i < 16; ++i) s += pp[i];
    P.PG[idx] = P.PG[idx] * geluf(s);
}
HD void it_peer_b(const Params& P, int ck, int l, long idx) {
    const int d4 = idx & 255; const int tl = idx >> 8; const int tok = P.cfg.ck_tok0[ck] + tl, s = P.cfg.ck_seq0[ck] + tl / P.cfg.ck_L[ck];
    const float* coef = P.PG + (size_t)tl * 128; const int* ix = P.PIDX + (size_t)tl * 128; const signed char* V = (const signed char*)P.PU + (size_t)l * 16384 * 2048 + 1024 + d4 * 4;
    float c[128], cmax = 0.f;
    for (int e = 0; e < 128; ++e) { c[e] = coef[e] * P.PVs[(size_t)l * 16384 + ix[e]]; cmax = fmaxf(cmax, fabsf(c[e])); }
    const float cinv = cmax > 0.f ? 127.0f / cmax : 0.f; int acc[4] = {0, 0, 0, 0};
    for (int e = 0; e < 128; ++e) { const signed char* v = V + (size_t)ix[e] * 2048; const int cq = (int)rintf(c[e] * cinv); for (int j = 0; j < 4; ++j) acc[j] += cq * (int)v[j]; }
    const float csc = cmax * (1.0f / 127.0f);
    const f32x4 accf = {(float)acc[0] * csc, (float)acc[1] * csc, (float)acc[2] * csc, (float)acc[3] * csc};
    const f32x4 g2 = *(const f32x4*)(ada_row(P, l, s) + 5120 + d4 * 4);
    f32x4* xo = (f32x4*)(P.out + (size_t)tok * DM + d4 * 4);
    *xo = *xo + g2 * accf;
}

namespace pg8 {
#define PG8_LAS __attribute__((address_space(3)))
constexpr int BM = 256, BK = 64, HALF = 128, HTB = HALF * BK * 2, STAGE_BYTES = 8 * HTB, NXCD = 8, WGM = 8;
HD int lds_byte(int r, int c) { const int st = (r >> 4) * 2 + (c >> 5), rr = r & 15, cc = c & 31, ob = rr * 64 + cc * 2; return st * 1024 + (ob ^ (((ob >> 9) & 1) << 5)); }
HD void stage_rc(int b, int& R, int& C) { const int st = b / 1024, sb = b % 1024, swz = sb ^ (((sb >> 9) & 1) << 5); R = (st >> 1) * 16 + swz / 64; C = (st & 1) * 32 + (swz % 64) / 2; }
HD int perm32(int rho) { const int n = rho >> 4, i = rho & 15; return 8 * (i >> 2) + 4 * n + (i & 3); }
struct Unit { int pm, pn; };
struct Gemm { const bf16_t* A; const bf16_t* Bt; int M, N, K, lda; const float* rs; const float* cs; };
struct StaticOrder {
    int nM, nN, nwg, G, c;
    HD void init(int M, int N, int G_, int c_) { nM = M / BM; nN = N / BM; nwg = nM * nN; G = G_; c = c_; }
    HD bool next(int i, Unit& u) const {
        const long L = (long)i * G + c; if (L >= nwg) return false;
        int wgid = (int)L; { const int q = nwg / NXCD, r = nwg % NXCD, xcd = wgid % NXCD, off = wgid / NXCD; wgid = (xcd < r ? xcd * (q + 1) : r * (q + 1) + (xcd - r) * q) + off; }
        const int nig = WGM * nN, gid = wgid / nig, fm = gid * WGM, gsz = (nM - fm) < WGM ? (nM - fm) : WGM;
        u.pm = fm + ((wgid % nig) % gsz); u.pn = (wgid % nig) / gsz; return true;
    }
    HD size_t a_off(const Unit&) const { return 0; }
};
struct BranchOrder {
    int nM, G, c;
    HD void init(int M, int G_, int c_) { nM = M / BM; G = G_; c = c_; }
    HD bool next(int i, Unit& u) const { const int cs = (G & 7) == 0 ? (c & 7) * (G >> 3) + (c >> 3) : c;
        const long tile = (long)(i >> 2) * G + cs; if (tile >= (long)nM * 4) return false; u.pm = (int)(tile >> 2); u.pn = (i & 3) * 4 + (int)(tile & 3); return true; }
    HD size_t a_off(const Unit& u) const { return (size_t)(u.pn >> 2) * 256 * 2; }
};

struct EpiCat {
    static constexpr bool PERM = true;
    bf16_t* proj; unsigned char* gates; const float* bgate; int pn_base; const float* rs; const float* cs;
    HD void operator()(const f32x4 (&acc)[2][2][4][2], const Unit& u, int wr, int wc, int fr, int fq) const {
        typedef int i32x4_ __attribute__((ext_vector_type(4)));
        const bool isg = pn_base >= 12;
        const int row0 = u.pm * BM + wr * 64 + fr; const int col0 = u.pn * BM + wc * 32 + 8 * fq;
#pragma unroll
        for (int bj = 0; bj < 2; ++bj) {
            f32x4 b0 = {0.f, 0.f, 0.f, 0.f}, b1 = b0, c0 = {1.f, 1.f, 1.f, 1.f}, c1 = c0;
            if (isg) { b0 = *(const f32x4*)(bgate + col0 + bj * HALF); b1 = *(const f32x4*)(bgate + col0 + bj * HALF + 4); }
            if (cs) { c0 = *(const f32x4*)(cs + col0 + bj * HALF); c1 = *(const f32x4*)(cs + col0 + bj * HALF + 4); }
#if DEV_CODE
            if (isg) { const float nl2e = -1.4426950408889634f; b0 *= nl2e; b1 *= nl2e; c0 *= nl2e; c1 *= nl2e; }
#endif
#pragma unroll
            for (int ai = 0; ai < 2; ++ai)
#pragma unroll
                for (int m = 0; m < 4; ++m) { const size_t row = (size_t)(row0 + ai * HALF + m * 16); f32x4 v0, v1;
                    if (cs) { const float r = rs[row]; v0 = __builtin_convertvector(__builtin_bit_cast(i32x4_, acc[ai][bj][m][0]), f32x4) * (c0 * r) + b0; v1 = __builtin_convertvector(__builtin_bit_cast(i32x4_, acc[ai][bj][m][1]), f32x4) * (c1 * r) + b1; }
#if DEV_CODE
                    else if (isg) { v0 = acc[ai][bj][m][0] * -1.4426950408889634f + b0; v1 = acc[ai][bj][m][1] * -1.4426950408889634f + b1; }
#endif
                    else { v0 = acc[ai][bj][m][0] + b0; v1 = acc[ai][bj][m][1] + b1; }
                    if (isg) { u32x2 w;
#if DEV_CODE
                        w.x = 0u; w.y = 0u;
#pragma unroll
                        for (int j = 0; j < 4; ++j) { w.x = __builtin_amdgcn_cvt_pk_u8_f32(__builtin_amdgcn_rcpf(1.0f + __builtin_amdgcn_exp2f(v0[j])) * 255.0f, j, w.x);
                                                      w.y = __builtin_amdgcn_cvt_pk_u8_f32(__builtin_amdgcn_rcpf(1.0f + __builtin_amdgcn_exp2f(v1[j])) * 255.0f, j, w.y); }
#else
                        unsigned q[8];
                        for (int j = 0; j < 4; ++j) { q[j] = (unsigned)(int)(sigmoidf(v0[j]) * 255.0f + 0.5f); q[4 + j] = (unsigned)(int)(sigmoidf(v1[j]) * 255.0f + 0.5f); }
                        w.x = q[0] | (q[1] << 8) | (q[2] << 16) | (q[3] << 24); w.y = q[4] | (q[5] << 8) | (q[6] << 16) | (q[7] << 24);
#endif
                        *(u32x2*)(gates + row * 4096 + col0 + bj * HALF) = w; }
                    else { u32x4 w; w.x = pack_bf16(v0[0], v0[1]); w.y = pack_bf16(v0[2], v0[3]); w.z = pack_bf16(v1[0], v1[1]); w.w = pack_bf16(v1[2], v1[3]);
                        *(u32x4*)(proj + row * NPROJ + col0 + bj * HALF) = w; } }
        }
    }
};
struct EpiBranch {
    static constexpr bool PERM = true;
    float* mrg32; bf16_t* mrg; const unsigned char* gates;
    template <bool RMW>
    HD void run(const f32x4 (&acc)[2][2][4][2], const unsigned char* gb, const unsigned row0, const unsigned col0) const {
        constexpr int EB_D = 6;
        u32x2 gw[16]; u32x4 mw[16];
#define EB_ROW(s) (row0 + (unsigned)(((s) >> 3) * HALF + (((s) >> 1) & 3) * 16))
#define EB_COL(s) (col0 + (unsigned)(((s) & 1) * HALF))
#pragma unroll
        for (int st = 0; st < EB_D; ++st) { gw[st] = *(const u32x2*)(gb + (EB_ROW(st) * 4096u + EB_COL(st))); if (RMW) mw[st] = *(const u32x4*)(mrg + (EB_ROW(st) * (unsigned)DM + EB_COL(st))); }
#pragma unroll
        for (int st = 0; st < 16; ++st) {
            if (st + EB_D < 16) { gw[(st + EB_D) & 15] = *(const u32x2*)(gb + (EB_ROW(st + EB_D) * 4096u + EB_COL(st + EB_D))); if (RMW) mw[(st + EB_D) & 15] = *(const u32x4*)(mrg + (EB_ROW(st + EB_D) * (unsigned)DM + EB_COL(st + EB_D))); }
#if DEV_CODE
            asm volatile("" ::: "memory");
#endif
            const int ai = st >> 3, m = (st >> 1) & 3, bj = st & 1; const float k255 = 1.0f / 255.0f; const u32x2 g = gw[st];
            f32x4 g0 = {(float)(g.x & 0xffu) * k255, (float)((g.x >> 8) & 0xffu) * k255, (float)((g.x >> 16) & 0xffu) * k255, (float)(g.x >> 24) * k255};
            f32x4 g1 = {(float)(g.y & 0xffu) * k255, (float)((g.y >> 8) & 0xffu) * k255, (float)((g.y >> 16) & 0xffu) * k255, (float)(g.y >> 24) * k255};
            f32x4 v0 = acc[ai][bj][m][0] * g0, v1 = acc[ai][bj][m][1] * g1;
            if (RMW) { const u32x4 w = mw[st];
                v0 += (f32x4){u2f(w.x << 16), u2f(w.x & 0xffff0000u), u2f(w.y << 16), u2f(w.y & 0xffff0000u)}; v1 += (f32x4){u2f(w.z << 16), u2f(w.z & 0xffff0000u), u2f(w.w << 16), u2f(w.w & 0xffff0000u)}; }
            u32x4 w; w.x = pack_bf16(v0[0], v0[1]); w.y = pack_bf16(v0[2], v0[3]); w.z = pack_bf16(v1[0], v1[1]); w.w = pack_bf16(v1[2], v1[3]);
            *(u32x4*)(mrg + (EB_ROW(st) * (unsigned)DM + EB_COL(st))) = w;
        }
#undef EB_ROW
#undef EB_COL
    }
    HD void operator()(const f32x4 (&acc)[2][2][4][2], const Unit& u, int wr, int wc, int fr, int fq) const {
        const int br = u.pn >> 2, jt = u.pn & 3; const unsigned row0 = u.pm * BM + wr * 64 + fr; const unsigned col0 = jt * BM + wc * 32 + 8 * fq;
        const unsigned char* gb = gates + br * 1024;
        if (br > 0) run<true>(acc, gb, row0, col0); else run<false>(acc, gb, row0, col0);
    }
};
#ifdef HOST_TEST
struct EpiOut {
    static constexpr bool PERM = false;
    const float* xin_p; const float* xin_s; float* xout; const float* ada_l; int tok0, seq0, L, n_prompt_tok;
    HD void operator()(const f32x4 (&acc)[2][2][4][2], const Unit& u, int wr, int wc, int fr, int fq) const {
        constexpr int EO_D = 2;
        const int row0 = u.pm * BM + wr * 64 + fr, col0 = u.pn * BM + wc * 32 + 4 * fq;
        const float* g1 = ada_l + (size_t)(seq0 + (u.pm * BM) / L) * 6144 + 2048;
        const bool smp = xin_s && (tok0 + u.pm * BM >= n_prompt_tok);
        const float* xb = smp ? xin_s + (size_t)(tok0 - n_prompt_tok) * DM : xin_p + (size_t)tok0 * DM;
        f32x4 gv[2][2], xv[8][2][2];
#pragma unroll
        for (int bj = 0; bj < 2; ++bj)
#pragma unroll
            for (int n = 0; n < 2; ++n) gv[bj][n] = *(const f32x4*)(g1 + col0 + bj * HALF + n * 16);
#define EO_ROW(s) (row0 + ((s) >> 2) * HALF + ((s) & 3) * 16)
#define EO_LOAD(s) do { _Pragma("unroll") for (int bj = 0; bj < 2; ++bj) _Pragma("unroll") for (int n = 0; n < 2; ++n) xv[(s) & 7][bj][n] = *(const f32x4*)(xb + (size_t)EO_ROW(s) * DM + col0 + bj * HALF + n * 16); } while (0)
#pragma unroll
        for (int st = 0; st < EO_D; ++st) EO_LOAD(st);
#pragma unroll
        for (int st = 0; st < 8; ++st) {
            if (st + EO_D < 8) EO_LOAD(st + EO_D);
#if DEV_CODE
            asm volatile("" ::: "memory");
#endif
            const int ai = st >> 2, m = st & 3; float* xo = xout + (size_t)(tok0 + EO_ROW(st)) * DM;
#pragma unroll
            for (int bj = 0; bj < 2; ++bj)
#pragma unroll
                for (int n = 0; n < 2; ++n) *(f32x4*)(xo + col0 + bj * HALF + n * 16) = xv[st][bj][n] + gv[bj][n] * acc[ai][bj][m][n];
        }
#undef EO_ROW
#undef EO_LOAD
    }
};
#else
struct EpiOut {
    static constexpr bool PERM = true;
    const float* xin_p; const float* xin_s; bf16_t* xb; const float* ada_l; int tok0, seq0, L, n_prompt_tok;
    template <bool L0>
    HD void run(const f32x4 (&acc)[2][2][4][2], const Unit& u, int wr, int wc, int fr, int fq) const {
        constexpr int EO_D = L0 ? 1 : 2;
        const int row0 = u.pm * BM + wr * 64 + fr, col0 = u.pn * BM + wc * 32 + 8 * fq;
        const float* g1 = ada_l + (size_t)(seq0 + (u.pm * BM) / L) * 6144 + 2048;
        const bool smp = tok0 + u.pm * BM >= n_prompt_tok;
        const float* xf = L0 ? (smp ? xin_s + (size_t)(tok0 - n_prompt_tok) * DM : xin_p + (size_t)tok0 * DM) : nullptr;
        f32x4 gv[2][2]; f32x4 xv[8][2][2]; u32x4 xw[8][2];
#pragma unroll
        for (int bj = 0; bj < 2; ++bj)
#pragma unroll
            for (int n = 0; n < 2; ++n) gv[bj][n] = *(const f32x4*)(g1 + col0 + bj * HALF + n * 4);
#define EO_ROW(s) (row0 + ((s) >> 2) * HALF + ((s) & 3) * 16)
#define EO_LOAD(s) do { _Pragma("unroll") for (int bj = 0; bj < 2; ++bj) { if (L0) { _Pragma("unroll") for (int n = 0; n < 2; ++n) xv[(s) & 7][bj][n] = *(const f32x4*)(xf + (size_t)EO_ROW(s) * DM + col0 + bj * HALF + n * 4); } \
            else xw[(s) & 7][bj] = *(const u32x4*)(xb + (size_t)EO_ROW(s) * DM + col0 + bj * HALF); } } while (0)
#pragma unroll
        for (int st = 0; st < EO_D; ++st) EO_LOAD(st);
#pragma unroll
        for (int st = 0; st < 8; ++st) {
            if (st + EO_D < 8) EO_LOAD(st + EO_D);
#if DEV_CODE
            asm volatile("" ::: "memory");
#endif
            const int ai = st >> 2, m = st & 3;
#pragma unroll
            for (int bj = 0; bj < 2; ++bj) { f32x4 x0, x1;
                if (L0) { x0 = xv[st][bj][0]; x1 = xv[st][bj][1]; }
                else { const u32x4 w = xw[st][bj]; x0 = (f32x4){u2f(w.x << 16), u2f(w.x & 0xffff0000u), u2f(w.y << 16), u2f(w.y & 0xffff0000u)}; x1 = (f32x4){u2f(w.z << 16), u2f(w.z & 0xffff0000u), u2f(w.w << 16), u2f(w.w & 0xffff0000u)}; }
                const f32x4 v0 = x0 + gv[bj][0] * acc[ai][bj][m][0], v1 = x1 + gv[bj][1] * acc[ai][bj][m][1];
                u32x4 o; o.x = pack_bf16(v0[0], v0[1]); o.y = pack_bf16(v0[2], v0[3]); o.z = pack_bf16(v1[0], v1[1]); o.w = pack_bf16(v1[2], v1[3]);
                *(u32x4*)(xb + (size_t)EO_ROW(st) * DM + col0 + bj * HALF) = o; }
        }
#undef EO_ROW
#undef EO_LOAD
    }
    HD void operator()(const f32x4 (&acc)[2][2][4][2], const Unit& u, int wr, int wc, int fr, int fq) const {
        if (xin_p) run<true>(acc, u, wr, wc, fr, fq); else run<false>(acc, u, wr, wc, fr, fq);
    }
};
#endif
struct EpiQ {
    static constexpr bool PERM = true;
    bf16_t* O; const float* bias; const float* rs; const float* cs;
    HD void operator()(const f32x4 (&acc)[2][2][4][2], const Unit& u, int wr, int wc, int fr, int fq) const {
        typedef int i32x4_ __attribute__((ext_vector_type(4)));
        const int row0 = u.pm * BM + wr * 64 + fr; const int col0 = u.pn * BM + wc * 32 + 8 * fq;
#pragma unroll
        for (int bj = 0; bj < 2; ++bj) {
            const f32x4 b0 = *(const f32x4*)(bias + col0 + bj * HALF), b1 = *(const f32x4*)(bias + col0 + bj * HALF + 4);
            f32x4 c0 = {1.f, 1.f, 1.f, 1.f}, c1 = {1.f, 1.f, 1.f, 1.f}; if (cs) { c0 = *(const f32x4*)(cs + col0 + bj * HALF); c1 = *(const f32x4*)(cs + col0 + bj * HALF + 4); }
#pragma unroll
            for (int ai = 0; ai < 2; ++ai)
#pragma unroll
                for (int m = 0; m < 4; ++m) { const int row = row0 + ai * HALF + m * 16; f32x4 v0, v1;
                    if (cs) { const float r = rs[row]; v0 = __builtin_convertvector(__builtin_bit_cast(i32x4_, acc[ai][bj][m][0]), f32x4) * (c0 * r) + b0; v1 = __builtin_convertvector(__builtin_bit_cast(i32x4_, acc[ai][bj][m][1]), f32x4) * (c1 * r) + b1; }
                    else { v0 = acc[ai][bj][m][0] + b0; v1 = acc[ai][bj][m][1] + b1; }
                    u32x4 w; w.x = pack_bf16(v0[0], v0[1]); w.y = pack_bf16(v0[2], v0[3]); w.z = pack_bf16(v1[0], v1[1]); w.w = pack_bf16(v1[2], v1[3]);
                    *(u32x4*)(O + (size_t)row * 2048 + col0 + bj * HALF) = w; }
        }
    }
};

#if DEV_CODE || !defined(HOST_TEST)
typedef int i32x4 __attribute__((ext_vector_type(4)));
template <class Epi, class Sched, bool I8 = false>
__device__ __forceinline__ void gemm_phase(PG8_LAS unsigned char* lds, const Gemm g, const Sched& S, const Epi& E, const int tid) {
    const int wid = __builtin_amdgcn_readfirstlane(tid >> 6), lane = tid & 63, wr = wid >> 2, wc = wid & 3, fr = lane & 15, fq = lane >> 4;
    const int K = g.K, nt = K / BK, lda = g.lda;
    unsigned voffA[2], voffB[2];
#pragma unroll
    for (int i = 0; i < 2; ++i) { int R, C; stage_rc(tid * 16 + i * 8192, R, C); const int Rb = Epi::PERM ? ((R & ~31) + perm32(R & 31)) : R;
        voffA[i] = (unsigned)(R * lda + C) * 2u; voffB[i] = (unsigned)(Rb * K + C) * 2u; }
    const size_t kstep = (size_t)(BK * 2);
    const size_t hstepA = (size_t)HALF * lda * 2, tstepA = 2 * hstepA;
    const size_t hstepB = (size_t)HALF * K * 2, tstepB = 2 * hstepB;
    const unsigned ldsw = (unsigned)wid * 1024u;
    const int aoff = lds_byte(wr * 64 + fr, fq * 8), boff = lds_byte(wc * 32 + fr, fq * 8);
#define PG8_SA(b, h) (((b) * 2 + (h)) * HTB)
#define PG8_SB(b, h) ((4 + (b) * 2 + (h)) * HTB)
#define PG8_STAGE(bufoff, gbase, voff) do { _Pragma("unroll") for (int _i = 0; _i < 2; ++_i) \
        __builtin_amdgcn_global_load_lds((const unsigned*)((const char*)(gbase) + (voff)[_i]), (PG8_LAS unsigned*)(lds + (bufoff) + ldsw + _i * 8192), 16, 0, 0); } while (0)
#define PG8_LDA(dst, b, h) do { _Pragma("unroll") for (int m = 0; m < 4; ++m) _Pragma("unroll") for (int k = 0; k < 2; ++k) dst[m][k] = *(const PG8_LAS bf16x8*)(lds + PG8_SA(b, h) + aoff + m * 2048 + k * 1024); } while (0)
#define PG8_LDB(dst, b, h) do { _Pragma("unroll") for (int n = 0; n < 2; ++n) _Pragma("unroll") for (int k = 0; k < 2; ++k) dst[n][k] = *(const PG8_LAS bf16x8*)(lds + PG8_SB(b, h) + boff + n * 2048 + k * 1024); } while (0)
#define PG8_MMA(ai, bj, At, Bt) do { __builtin_amdgcn_s_setprio(1); _Pragma("unroll") for (int m = 0; m < 4; ++m) _Pragma("unroll") for (int n = 0; n < 2; ++n) _Pragma("unroll") for (int k = 0; k < 2; ++k) \
        { if constexpr (I8) acc[ai][bj][m][n] = __builtin_bit_cast(f32x4, __builtin_amdgcn_mfma_i32_16x16x64_i8(__builtin_bit_cast(i32x4, Bt[n][k]), __builtin_bit_cast(i32x4, At[m][k]), __builtin_bit_cast(i32x4, acc[ai][bj][m][n]), 0, 0, 0)); \
          else acc[ai][bj][m][n] = __builtin_amdgcn_mfma_f32_16x16x32_bf16(Bt[n][k], At[m][k], acc[ai][bj][m][n], 0, 0, 0); } __builtin_amdgcn_s_setprio(0); } while (0)
#define PG8_WAIT_V(n) asm volatile("s_waitcnt vmcnt(" #n ")" ::: "memory")
#define PG8_WAIT_L(n) asm volatile("s_waitcnt lgkmcnt(" #n ")" ::: "memory")
#define PG8_BAR __builtin_amdgcn_s_barrier()
#define PG8_SCHED __builtin_amdgcn_sched_barrier(0)
    Unit cur, nxt; int ui = 0;
    if (!S.next(0, cur)) return;
    f32x4 acc[2][2][4][2];
#pragma unroll
    for (int a = 0; a < 2; ++a)
#pragma unroll
        for (int b = 0; b < 2; ++b)
#pragma unroll
            for (int m = 0; m < 4; ++m)
#pragma unroll
                for (int n = 0; n < 2; ++n) acc[a][b][m][n] = (f32x4){0.f, 0.f, 0.f, 0.f};
    bf16x8 At[4][2], B0[2][2], B1[2][2];
    const char* cA = (const char*)g.A + (size_t)cur.pm * tstepA + S.a_off(cur); const char* cB = (const char*)g.Bt + (size_t)cur.pn * tstepB;
    PG8_STAGE(PG8_SB(0, 0), cB, voffB); PG8_STAGE(PG8_SB(0, 1), cB + hstepB, voffB); PG8_STAGE(PG8_SA(0, 0), cA, voffA); PG8_STAGE(PG8_SA(0, 1), cA + hstepA, voffA);
    if (wr == 1) PG8_BAR;
    PG8_WAIT_V(2); PG8_BAR;
    PG8_STAGE(PG8_SB(1, 0), cB + kstep, voffB); PG8_STAGE(PG8_SA(1, 0), cA + kstep, voffA); PG8_STAGE(PG8_SB(1, 1), cB + hstepB + kstep, voffB);
    PG8_WAIT_V(6); PG8_BAR;
    for (;;) {
        const bool has_next = S.next(ui + 1, nxt);
        const char* nA = has_next ? (const char*)g.A + (size_t)nxt.pm * tstepA + S.a_off(nxt) : cA; const char* nB = has_next ? (const char*)g.Bt + (size_t)nxt.pn * tstepB : cB;
#pragma nounroll
        for (int t = 0; t < nt; t += 2) {
            const bool last = (t == nt - 2);
            const char* a1 = cA + (size_t)(t + 1) * kstep;
            const char* a2 = last ? nA : cA + (size_t)(t + 2) * kstep; const char* b2 = last ? nB : cB + (size_t)(t + 2) * kstep;
            const char* a3 = a2 + kstep; const char* b3 = b2 + kstep;
            PG8_LDB(B0, 0, 0); PG8_LDB(B1, 0, 1); PG8_SCHED; PG8_LDA(At, 0, 0); PG8_STAGE(PG8_SA(1, 1), a1 + hstepA, voffA);
            PG8_WAIT_V(8); PG8_WAIT_L(0); PG8_BAR; PG8_MMA(0, 0, At, B0); PG8_MMA(0, 1, At, B1); PG8_BAR; PG8_SCHED;
            PG8_LDA(At, 0, 1); PG8_STAGE(PG8_SB(0, 0), b2, voffB); PG8_STAGE(PG8_SB(0, 1), b2 + hstepB, voffB); PG8_STAGE(PG8_SA(0, 0), a2, voffA);
            PG8_WAIT_V(8); PG8_WAIT_L(0); PG8_BAR; PG8_MMA(1, 0, At, B0); PG8_MMA(1, 1, At, B1); PG8_BAR; PG8_SCHED;
            PG8_LDB(B0, 1, 0); PG8_LDB(B1, 1, 1); PG8_SCHED; PG8_LDA(At, 1, 0); PG8_STAGE(PG8_SA(0, 1), a2 + hstepA, voffA);
            PG8_WAIT_V(8); PG8_WAIT_L(0); PG8_BAR; PG8_MMA(0, 0, At, B0); PG8_MMA(0, 1, At, B1); PG8_BAR; PG8_SCHED;
            PG8_LDA(At, 1, 1); PG8_STAGE(PG8_SB(1, 0), b3, voffB); PG8_STAGE(PG8_SB(1, 1), b3 + hstepB, voffB); PG8_STAGE(PG8_SA(1, 0), a3, voffA);
            PG8_WAIT_V(8); PG8_WAIT_L(0); PG8_BAR; PG8_MMA(1, 0, At, B0); PG8_MMA(1, 1, At, B1); PG8_BAR; PG8_SCHED;
        }
        if (wr == 0) PG8_BAR;
        E(acc, cur, wr, wc, fr, fq);
        if (!has_next) break;
#pragma unroll
        for (int a = 0; a < 2; ++a)
#pragma unroll
            for (int b = 0; b < 2; ++b)
#pragma unroll
                for (int m = 0; m < 4; ++m)
#pragma unroll
                    for (int n = 0; n < 2; ++n) acc[a][b][m][n] = (f32x4){0.f, 0.f, 0.f, 0.f};
        cur = nxt; cA = nA; cB = nB; ++ui;
        if (wr == 1) PG8_BAR;
    }
    PG8_WAIT_V(0);
    PG8_BAR;
#undef PG8_SA
#undef PG8_SB
#undef PG8_STAGE
#undef PG8_LDA
#undef PG8_LDB
#undef PG8_MMA
#undef PG8_WAIT_V
#undef PG8_WAIT_L
#undef PG8_BAR
#undef PG8_SCHED
}
#endif
}

#define XB_TMO      128
#define XB_XCNT(j)  (256  + 64 * (j))
#define XB_XSUB(j)  (1280 + 64 * (j))
#define XB_XGEN(j)  (2304 + 64 * (j))
#define XB_TOP      3328
#define XB_TOPGEN   3392
#define XCD_BAR_WORDS 3456
#define XB_SPIN_CAP (1u << 24)
#define LAS __attribute__((address_space(3)))
#if DEV_CODE || !defined(HOST_TEST)
__device__ __forceinline__ unsigned xb_ld(unsigned* p)              { return __hip_atomic_load(p, __ATOMIC_RELAXED, __HIP_MEMORY_SCOPE_AGENT); }
__device__ __forceinline__ unsigned xb_add(unsigned* p, unsigned v) { return __hip_atomic_fetch_add(p, v, __ATOMIC_RELAXED, __HIP_MEMORY_SCOPE_AGENT); }
__device__ __forceinline__ unsigned xb_xcc_id() { return (unsigned)__builtin_amdgcn_s_getreg((3 << 11) | 20) & 0xFu; }
#define XB_SPIN(cond, bar) do { unsigned _sp = 0; while (cond) { __builtin_amdgcn_s_sleep(1); \
    if ((++_sp & 255u) == 0u) { if (xb_ld(&(bar)[XB_TMO])) break; if (_sp > XB_SPIN_CAP) { atomicAdd(&(bar)[XB_TMO], 1u); break; } } } } while (0)
struct XcdBarrier { unsigned* bar; unsigned x; volatile LAS unsigned* st; };
__device__ __forceinline__ XcdBarrier xcd_barrier_post(unsigned* bar, volatile LAS unsigned* st) {
    XcdBarrier b; b.bar = bar; b.x = xb_xcc_id(); b.st = st;
    if (threadIdx.x == 0) (void)xb_add(&bar[XB_XCNT(b.x)], 1u);
    return b;
}
__device__ __forceinline__ void xcd_barrier_complete(unsigned* bar, unsigned x, unsigned& nloc, unsigned& nx) {
    const unsigned G = gridDim.x * gridDim.y * gridDim.z;
    unsigned sum, cnt, mine, sp = 0u;
    for (;;) {
        sum = 0u; cnt = 0u; mine = 0u;
#pragma unroll
        for (unsigned j = 0; j < 16; ++j) { const unsigned c = xb_ld(&bar[XB_XCNT(j)]); sum += c; cnt += (c > 0u) ? 1u : 0u; mine = (j == x) ? c : mine; }
        if (sum == G) break;
        __builtin_amdgcn_s_sleep(1);
        if ((++sp & 255u) == 0u) { if (xb_ld(&bar[XB_TMO])) break; if (sp > XB_SPIN_CAP) { atomicAdd(&bar[XB_TMO], 1u); break; } }
    }
    nloc = mine > 0u ? mine : 1u; nx = cnt > 0u ? cnt : 1u;
}
template <bool FIRST>
__device__ __forceinline__ void xcd_barrier(const XcdBarrier& b) {
    asm volatile("s_waitcnt vmcnt(0)" ::: "memory");
    __syncthreads();
    if (threadIdx.x == 0) {
        unsigned* bar = b.bar;
        __builtin_amdgcn_s_waitcnt(0);
        unsigned nloc = b.st[0], nx = b.st[1];
        if constexpr (FIRST) { if (nloc == 0u) { xcd_barrier_complete(bar, b.x, nloc, nx); b.st[0] = nloc; b.st[1] = nx; } }
        else { nloc = nloc ? nloc : 1u; nx = nx ? nx : 1u; }
        const unsigned old = xb_add(&bar[XB_XSUB(b.x)], 1u);
        const unsigned gen = old / nloc;
        if (old + 1u == (gen + 1u) * nloc) {
            __builtin_amdgcn_fence(__ATOMIC_RELEASE, "agent");
            asm volatile("s_waitcnt vmcnt(0)" ::: "memory");
            const unsigned og = xb_add(&bar[XB_TOP], 1u);
            const unsigned tg = og / nx;
            if (og + 1u == (tg + 1u) * nx) xb_add(&bar[XB_TOPGEN], 1u);
            else XB_SPIN(xb_ld(&bar[XB_TOPGEN]) == tg, bar);
            __builtin_amdgcn_fence(__ATOMIC_ACQUIRE, "agent");
            xb_add(&bar[XB_XGEN(b.x)], 1u);
            asm volatile("s_waitcnt vmcnt(0)" ::: "memory");
        } else {
            XB_SPIN(xb_ld(&bar[XB_XGEN(b.x)]) == gen, bar);
            __builtin_amdgcn_fence(__ATOMIC_ACQUIRE, "agent");
            asm volatile("s_waitcnt vmcnt(0)" ::: "memory");
        }
    }
    __syncthreads();
}
#endif


#if DEV_CODE || !defined(HOST_TEST)
#define DPP_ADD(v, ctrl) ((v) + __builtin_bit_cast(float, __builtin_amdgcn_update_dpp(0, __builtin_bit_cast(int, (v)), (ctrl), 0xf, 0xf, true)))
__device__ __forceinline__ float row_sum16(float v) { v = DPP_ADD(v, 0xB1); v = DPP_ADD(v, 0x4E); v = DPP_ADD(v, 0x141); v = DPP_ADD(v, 0x140); return v; }
__device__ __forceinline__ float wave_sum(float v) {
    v = row_sum16(v); const int b = __builtin_bit_cast(int, v);
    return (__builtin_bit_cast(float, __builtin_amdgcn_readlane(b, 0)) + __builtin_bit_cast(float, __builtin_amdgcn_readlane(b, 16))) + (__builtin_bit_cast(float, __builtin_amdgcn_readlane(b, 32)) + __builtin_bit_cast(float, __builtin_amdgcn_readlane(b, 48)));
}
#define DPP_MAXNN(v, ctrl) fmaxf((v), __builtin_bit_cast(float, __builtin_amdgcn_update_dpp(0, __builtin_bit_cast(int, (v)), (ctrl), 0xf, 0xf, true)))
__device__ __forceinline__ float wave_max_nn(float v) {
    v = DPP_MAXNN(v, 0xB1); v = DPP_MAXNN(v, 0x4E); v = DPP_MAXNN(v, 0x141); v = DPP_MAXNN(v, 0x140); const int b = __builtin_bit_cast(int, v);
    return fmaxf(fmaxf(__builtin_bit_cast(float, __builtin_amdgcn_readlane(b, 0)), __builtin_bit_cast(float, __builtin_amdgcn_readlane(b, 16))), fmaxf(__builtin_bit_cast(float, __builtin_amdgcn_readlane(b, 32)), __builtin_bit_cast(float, __builtin_amdgcn_readlane(b, 48))));
}
#define DPP_ADDI(v, ctrl) ((v) + __builtin_amdgcn_update_dpp(0, (v), (ctrl), 0xf, 0xf, true))
__device__ __forceinline__ int wave_sum_i32(int v) {
    v = DPP_ADDI(v, 0xB1); v = DPP_ADDI(v, 0x4E); v = DPP_ADDI(v, 0x141); v = DPP_ADDI(v, 0x140);
    return (__builtin_amdgcn_readlane(v, 0) + __builtin_amdgcn_readlane(v, 16)) + (__builtin_amdgcn_readlane(v, 32) + __builtin_amdgcn_readlane(v, 48));
}
__device__ __forceinline__ void unpack8(const u32x4 w, float* f) {
    f[0] = u2f(w.x << 16); f[1] = u2f(w.x & 0xffff0000u); f[2] = u2f(w.y << 16); f[3] = u2f(w.y & 0xffff0000u);
    f[4] = u2f(w.z << 16); f[5] = u2f(w.z & 0xffff0000u); f[6] = u2f(w.w << 16); f[7] = u2f(w.w & 0xffff0000u);
}
__device__ __forceinline__ void dev_norm(const Params& P, int ck, int l, int which, int tid) {
    constexpr int NB = 4;
    const int wave = tid >> 6, lane = tid & 63; const int T = P.cfg.ck_nseq[ck] * P.cfg.ck_L[ck];
    const float* nw = P.in[which ? IN_NORM2_W : IN_NORM1_W] + l * DM;
    for (int g = blockIdx.x * 8 + wave; g < T / NB; g += gridDim.x * 8) {
        const int tl0 = g * NB; const int s = P.cfg.ck_seq0[ck] + tl0 / P.cfg.ck_L[ck];
        const float* ad = ada_row(P, l, s) + (which ? 3072 : 0);
        f32x4 xv[NB][4]; float r[NB], hmax[NB];
#pragma unroll
        for (int b = 0; b < NB; ++b) { const int tok = P.cfg.ck_tok0[ck] + tl0 + b;
            if (which == 0) { const float* x = x_row_in(P, tok);
#pragma unroll
                for (int i = 0; i < 4; ++i) xv[b][i] = *(const f32x4*)(x + lane * 4 + 256 * i); }
            else { const bf16_t* x = P.XB + (size_t)(tl0 + b) * DM;
#pragma unroll
                for (int i = 0; i < 4; ++i) { const u32x2 w = *(const u32x2*)(x + lane * 4 + 256 * i); xv[b][i] = (f32x4){u2f(w.x << 16), u2f(w.x & 0xffff0000u), u2f(w.y << 16), u2f(w.y & 0xffff0000u)}; } } }
#pragma unroll
        for (int b = 0; b < NB; ++b) { float ss = 0.f;
#pragma unroll
            for (int i = 0; i < 4; ++i) ss += xv[b][i][0] * xv[b][i][0] + xv[b][i][1] * xv[b][i][1] + xv[b][i][2] * xv[b][i][2] + xv[b][i][3] * xv[b][i][3];
            ss = wave_sum(ss); r[b] = 1.0f / sqrtf(ss * (1.0f / DM) + 1e-6f); hmax[b] = 0.f; }
#pragma unroll
        for (int i = 0; i < 4; ++i) { const int k = lane * 4 + 256 * i;
            const f32x4 w = *(const f32x4*)(nw + k), sc = *(const f32x4*)(ad + 1024 + k), sh = *(const f32x4*)(ad + k);
#pragma unroll
            for (int b = 0; b < NB; ++b) { const f32x4 hv = xv[b][i] * r[b] * w * (1.0f + sc) + sh; xv[b][i] = hv;
                u32x2 o; o.x = pack_bf16(hv[0], hv[1]); o.y = pack_bf16(hv[2], hv[3]);
                *(u32x2*)(P.H + (size_t)(tl0 + b) * DM + k) = o;
                hmax[b] = fmaxf(hmax[b], fmaxf(fmaxf(fabsf(hv[0]), fabsf(hv[1])), fmaxf(fabsf(hv[2]), fabsf(hv[3])))); } }
#pragma unroll
        for (int b = 0; b < NB; ++b) { float hm = hmax[b];
            hm = wave_max_nn(hm);
            const float hinv = hm > 0.f ? 127.0f / hm : 0.f;
#pragma unroll
            for (int i = 0; i < 4; ++i) { const f32x4 hv = xv[b][i]; const unsigned q = ((unsigned)(int)rintf(hv[0] * hinv) & 0xffu) | (((unsigned)(int)rintf(hv[1] * hinv) & 0xffu) << 8) | (((unsigned)(int)rintf(hv[2] * hinv) & 0xffu) << 16) | (((unsigned)(int)rintf(hv[3] * hinv) & 0xffu) << 24);
                *(unsigned*)(P.HQ + (size_t)(tl0 + b) * DM + lane * 4 + 256 * i) = q; }
            if (lane == 0) P.HS[tl0 + b] = hm * (1.0f / 127.0f); }
    }
}
__device__ __forceinline__ void dev_dt(const Params& P, int ck, int l, int tid) {
    const int wave = tid >> 6, lane = tid & 63, lq = lane & 15, q4 = lane >> 4; const int T = P.cfg.ck_nseq[ck] * P.cfg.ck_L[ck];
    const bf16_t* wa = P.WDT + ((size_t)l * 16 + lq) * DM + 8 * q4;
    const int kh = wave & 1;
    for (int u = blockIdx.x * 4 + (wave >> 1); u < T / 16; u += gridDim.x * 4) {
        const bf16_t* hb = P.H + ((size_t)u * 16 + lq) * DM + 8 * q4 + kh * 512; const bf16_t* wk = wa + kh * 512; f32x4 acc = {0.f, 0.f, 0.f, 0.f};
#pragma unroll
        for (int ks = 0; ks < 16; ++ks) acc = __builtin_amdgcn_mfma_f32_16x16x32_bf16(*(const bf16x8*)(wk + ks * 32), *(const bf16x8*)(hb + ks * 32), acc, 0, 0, 0);
        if (q4 < 2) *(f32x4*)((kh ? P.DT2 : P.DT) + ((size_t)u * 16 + lq) * 8 + 4 * q4) = acc;
    }
}

__device__ __forceinline__ void dev_quant_wrows(const Params& P, int tid) {
    const int wave = tid >> 6, lane = tid & 63; const int per_layer = 4096 + 2048; const int nrow = P.cfg.depth * per_layer;
    for (int r2 = blockIdx.x * 8 + wave; r2 < nrow; r2 += gridDim.x * 8) {
        const int l = r2 / per_layer, r = r2 % per_layer; const bool isq = r >= 4096; const int rr = isq ? r - 4096 : r;
        const bf16_t* src = isq ? P.wq_t + ((size_t)l * 2048 + rr) * DM : P.wcat_t + ((size_t)l * NCAT + NPROJ + rr) * DM;
        float x[16]; unpack8(*(const u32x4*)(src + lane * 16), x); unpack8(*(const u32x4*)(src + lane * 16 + 8), x + 8);
        float amax = 0.f;
#pragma unroll
        for (int i = 0; i < 16; ++i) amax = fmaxf(amax, fabsf(x[i]));
        amax = wave_max_nn(amax);
        const float sc = amax > 0.f ? amax * (1.0f / 127.0f) : 1.0f, inv = 1.0f / sc; u32x4 w;
#pragma unroll
        for (int i = 0; i < 4; ++i) w[i] = ((unsigned)(int)rintf(x[4 * i] * inv) & 0xffu) | (((unsigned)(int)rintf(x[4 * i + 1] * inv) & 0xffu) << 8) | (((unsigned)(int)rintf(x[4 * i + 2] * inv) & 0xffu) << 16) | (((unsigned)(int)rintf(x[4 * i + 3] * inv) & 0xffu) << 24);
        signed char* dst = isq ? P.WQ8 + ((size_t)l * 2048 + rr) * DM : P.WG8 + ((size_t)l * 4096 + rr) * DM;
        *(u32x4*)(dst + lane * 16) = w;
        if (lane == 0) (isq ? P.WQS + (size_t)l * 2048 : P.WGS + (size_t)l * 4096)[rr] = sc;
    }
}
__device__ __forceinline__ void dev_quant_uv(const Params& P, int tid) {
    constexpr int RB = 2;
    const int wave = tid >> 6, lane = tid & 63; const long nrow = (long)P.cfg.depth * 16384;
    for (long g = (long)blockIdx.x * 8 + wave; g < 2 * nrow / RB; g += (long)gridDim.x * 8) {
        f32x4 x[RB][4];
#pragma unroll
        for (int b = 0; b < RB; ++b) { const long r2 = g * RB + b; const bool isv = r2 >= nrow; const long r = isv ? r2 - nrow : r2; const float* src = P.in[isv ? IN_PEER_V : IN_PEER_U] + r * DM + lane * 16;
#pragma unroll
            for (int i = 0; i < 4; ++i) x[b][i] = *(const f32x4*)(src + 4 * i); }
#pragma unroll
        for (int b = 0; b < RB; ++b) { const long r2 = g * RB + b; const bool isv = r2 >= nrow; const long r = isv ? r2 - nrow : r2; float amax = 0.f;
#pragma unroll
            for (int i = 0; i < 4; ++i) amax = fmaxf(amax, fmaxf(fmaxf(fabsf(x[b][i][0]), fabsf(x[b][i][1])), fmaxf(fabsf(x[b][i][2]), fabsf(x[b][i][3]))));
            amax = wave_max_nn(amax);
            const float sc = amax > 0.f ? amax * (1.0f / 127.0f) : 1.0f, inv = 1.0f / sc;
            u32x4 w;
#pragma unroll
            for (int i = 0; i < 4; ++i) { const unsigned b0 = (unsigned)(int)rintf(x[b][i][0] * inv) & 0xffu, b1 = (unsigned)(int)rintf(x[b][i][1] * inv) & 0xffu, b2 = (unsigned)(int)rintf(x[b][i][2] * inv) & 0xffu, b3 = (unsigned)(int)rintf(x[b][i][3] * inv) & 0xffu;
                w[i] = b0 | (b1 << 8) | (b2 << 16) | (b3 << 24); }
            *(u32x4*)(P.PU + r * 2048 + (isv ? 1024 : 0) + lane * 16) = w;
            if (lane == 0) (isv ? P.PVs : P.PUs)[r] = sc; }
    }
}
__device__ __forceinline__ void ub16_to_f(const u32x4 w, float* f) {
#pragma unroll
    for (int i = 0; i < 4; ++i) { f[4 * i] = (float)(w[i] & 0xffu); f[4 * i + 1] = (float)((w[i] >> 8) & 0xffu); f[4 * i + 2] = (float)((w[i] >> 16) & 0xffu); f[4 * i + 3] = (float)(w[i] >> 24); }
}
#define PEER_IX4(IX, q) do { const int q_ = (q) < 32 ? (q) : 31; const int mi_ = (q_ >> 4) ? my_i1 : my_i0; \
        _Pragma("unroll") for (int j = 0; j < 4; ++j) IX[j] = __builtin_amdgcn_readlane(mi_, (q_ & 15) * 4 + j); } while (0)
#define PEER_LOAD4(B, base, IX) do { _Pragma("unroll") for (int j = 0; j < 4; ++j) B[j] = *(const u32x4*)((base) + (size_t)IX[j] * 2048); } while (0)
#define PEER_DOT4(B, q) do { _Pragma("unroll") for (int j = 0; j < 4; ++j) { int t = __builtin_amdgcn_sdot4((int)hq.x, (int)B[j].x, 0, false); t = __builtin_amdgcn_sdot4((int)hq.y, (int)B[j].y, t, false); \
            t = __builtin_amdgcn_sdot4((int)hq.z, (int)B[j].z, t, false); t = __builtin_amdgcn_sdot4((int)hq.w, (int)B[j].w, t, false); \
            const int dsum = wave_sum_i32(t); const bool mine_ = lane == (((q) & 15) * 4 + j); \
            if ((q) >> 4) dl1 = mine_ ? dsum : dl1; else dl0 = mine_ ? dsum : dl0; } } while (0)
#define PEER_ACC4(B, q) do { const int c4_ = __builtin_amdgcn_readlane(((q) >> 4) ? pk1 : pk0, (q) & 15); \
        _Pragma("unroll") for (int k = 0; k < 4; ++k) { \
            const unsigned t0 = __builtin_amdgcn_perm(B[1][k], B[0][k], 0x05010400u), t1 = __builtin_amdgcn_perm(B[1][k], B[0][k], 0x07030602u), t2 = __builtin_amdgcn_perm(B[3][k], B[2][k], 0x05010400u), t3 = __builtin_amdgcn_perm(B[3][k], B[2][k], 0x07030602u); \
            acci[4 * k + 0] = __builtin_amdgcn_sdot4((int)__builtin_amdgcn_perm(t2, t0, 0x05040100u), c4_, acci[4 * k + 0], false); acci[4 * k + 1] = __builtin_amdgcn_sdot4((int)__builtin_amdgcn_perm(t2, t0, 0x07060302u), c4_, acci[4 * k + 1], false); \
            acci[4 * k + 2] = __builtin_amdgcn_sdot4((int)__builtin_amdgcn_perm(t3, t1, 0x05040100u), c4_, acci[4 * k + 2], false); acci[4 * k + 3] = __builtin_amdgcn_sdot4((int)__builtin_amdgcn_perm(t3, t1, 0x07060302u), c4_, acci[4 * k + 3], false); } } while (0)
__device__ __forceinline__ void dev_peer(const Params& P, int ck, int l, int tid, bool dry = false) {
    const int wave = tid >> 6, lane = tid & 63; const int T = P.cfg.ck_nseq[ck] * P.cfg.ck_L[ck];
    const unsigned char* PUl = P.PU + (size_t)l * 16384 * 2048 + lane * 16; const unsigned char* PVl = PUl + 1024;
    const float* su = P.PUs + (size_t)l * 16384; const float* sv = P.PVs + (size_t)l * 16384;
    for (int tl = blockIdx.x * 8 + wave; tl < T; tl += gridDim.x * 8) {
        float acc[16]; float cs = 0.f;
        const int my_i0 = P.PIDX[(size_t)tl * 128 + lane], my_i1 = P.PIDX[(size_t)tl * 128 + 64 + lane];
        const u32x4 hq = *(const u32x4*)(P.HQ + (size_t)tl * DM + lane * 16); const float hsc = P.HS[tl];
#pragma unroll
        for (int i = 0; i < 16; ++i) acc[i] = 0.f;
        const float my_g0 = P.PG[(size_t)tl * 128 + lane] * sv[my_i0], my_g1 = P.PG[(size_t)tl * 128 + 64 + lane] * sv[my_i1], my_s0 = su[my_i0] * hsc, my_s1 = su[my_i1] * hsc;
        asm volatile("" :: "v"(my_i0), "v"(my_i1), "v"(my_g0), "v"(my_g1), "v"(my_s0), "v"(my_s1));
        u32x4 A[4], B[4], C[4], D[4]; int ixa[4], ixb[4], ixc[4], ixd[4]; int dl0 = 0, dl1 = 0;
        PEER_IX4(ixa, 0); PEER_IX4(ixb, 1); PEER_IX4(ixc, 2); PEER_IX4(ixd, 3);
        PEER_LOAD4(A, PUl, ixa); PEER_LOAD4(B, PUl, ixb); PEER_LOAD4(C, PUl, ixc); PEER_LOAD4(D, PUl, ixd);
#pragma unroll 1
        for (int q = 0; q < 28; q += 4) {
            PEER_IX4(ixa, q + 4); PEER_DOT4(A, q); PEER_LOAD4(A, PUl, ixa); __builtin_amdgcn_sched_barrier(0);
            PEER_IX4(ixb, q + 5); PEER_DOT4(B, q + 1); PEER_LOAD4(B, PUl, ixb); __builtin_amdgcn_sched_barrier(0);
            PEER_IX4(ixc, q + 6); PEER_DOT4(C, q + 2); PEER_LOAD4(C, PUl, ixc); __builtin_amdgcn_sched_barrier(0);
            PEER_IX4(ixd, q + 7); PEER_DOT4(D, q + 3); PEER_LOAD4(D, PUl, ixd); __builtin_amdgcn_sched_barrier(0);
        }
        PEER_IX4(ixa, 0); PEER_DOT4(A, 28); PEER_LOAD4(A, PVl, ixa); __builtin_amdgcn_sched_barrier(0);
        PEER_IX4(ixb, 1); PEER_DOT4(B, 29); PEER_LOAD4(B, PVl, ixb); __builtin_amdgcn_sched_barrier(0);
        PEER_IX4(ixc, 2); PEER_DOT4(C, 30); PEER_LOAD4(C, PVl, ixc); __builtin_amdgcn_sched_barrier(0);
        PEER_IX4(ixd, 3); PEER_DOT4(D, 31); PEER_LOAD4(D, PVl, ixd); __builtin_amdgcn_sched_barrier(0);
        const float c0 = my_g0 * gelu_as((float)dl0 * my_s0), c1 = my_g1 * gelu_as((float)dl1 * my_s1);
        float cmax = fmaxf(fabsf(c0), fabsf(c1));
        cmax = wave_max_nn(cmax);
        const float cinv = cmax > 0.f ? 127.0f / cmax : 0.f, csc = cmax * (1.0f / 127.0f);
        const int cq0 = (int)rintf(c0 * cinv) & 0xff, cq1 = (int)rintf(c1 * cinv) & 0xff; const int l4 = (lane & 15) * 4;
        const int pk0 = __shfl(cq0, l4) | (__shfl(cq0, l4 + 1) << 8) | (__shfl(cq0, l4 + 2) << 16) | (__shfl(cq0, l4 + 3) << 24);
        const int pk1 = __shfl(cq1, l4) | (__shfl(cq1, l4 + 1) << 8) | (__shfl(cq1, l4 + 2) << 16) | (__shfl(cq1, l4 + 3) << 24);
        int acci[16];
#pragma unroll
        for (int i = 0; i < 16; ++i) acci[i] = 0;
#pragma unroll 1
        for (int q = 0; q < 28; q += 4) {
            PEER_IX4(ixa, q + 4); PEER_ACC4(A, q); PEER_LOAD4(A, PVl, ixa); __builtin_amdgcn_sched_barrier(0);
            PEER_IX4(ixb, q + 5); PEER_ACC4(B, q + 1); PEER_LOAD4(B, PVl, ixb); __builtin_amdgcn_sched_barrier(0);
            PEER_IX4(ixc, q + 6); PEER_ACC4(C, q + 2); PEER_LOAD4(C, PVl, ixc); __builtin_amdgcn_sched_barrier(0);
            PEER_IX4(ixd, q + 7); PEER_ACC4(D, q + 3); PEER_LOAD4(D, PVl, ixd); __builtin_amdgcn_sched_barrier(0);
        }
        PEER_ACC4(A, 28); __builtin_amdgcn_sched_barrier(0); PEER_ACC4(B, 29); __builtin_amdgcn_sched_barrier(0); PEER_ACC4(C, 30); __builtin_amdgcn_sched_barrier(0); PEER_ACC4(D, 31);
        const int tok = P.cfg.ck_tok0[ck] + tl, s = P.cfg.ck_seq0[ck] + tl / P.cfg.ck_L[ck];
#pragma unroll
        for (int i = 0; i < 16; ++i) acc[i] = (float)acci[i] * csc;
        cs = 0.f;
        const float* g2 = ada_row(P, l, s) + 5120 + lane * 16; float* xo = P.out + (size_t)tok * DM + lane * 16; bf16_t* xbr = P.XB + (size_t)tl * DM + lane * 16;
        f32x4 xn[4]; float ss = 0.f; const u32x4 xw0 = *(const u32x4*)xbr, xw1 = *(const u32x4*)(xbr + 8);
        const f32x4 xold[4] = {{u2f(xw0.x << 16), u2f(xw0.x & 0xffff0000u), u2f(xw0.y << 16), u2f(xw0.y & 0xffff0000u)}, {u2f(xw0.z << 16), u2f(xw0.z & 0xffff0000u), u2f(xw0.w << 16), u2f(xw0.w & 0xffff0000u)},
                               {u2f(xw1.x << 16), u2f(xw1.x & 0xffff0000u), u2f(xw1.y << 16), u2f(xw1.y & 0xffff0000u)}, {u2f(xw1.z << 16), u2f(xw1.z & 0xffff0000u), u2f(xw1.w << 16), u2f(xw1.w & 0xffff0000u)}};
#pragma unroll
        for (int q = 0; q < 4; ++q) { const f32x4 a = {acc[q * 4] - cs, acc[q * 4 + 1] - cs, acc[q * 4 + 2] - cs, acc[q * 4 + 3] - cs};
            xn[q] = xold[q] + *(const f32x4*)(g2 + 4 * q) * a; ss += xn[q][0] * xn[q][0] + xn[q][1] * xn[q][1] + xn[q][2] * xn[q][2] + xn[q][3] * xn[q][3]; }
        if (l + 1 < P.cfg.depth) { u32x4 o0, o1;
            o0.x = pack_bf16(xn[0][0], xn[0][1]); o0.y = pack_bf16(xn[0][2], xn[0][3]); o0.z = pack_bf16(xn[1][0], xn[1][1]); o0.w = pack_bf16(xn[1][2], xn[1][3]);
            o1.x = pack_bf16(xn[2][0], xn[2][1]); o1.y = pack_bf16(xn[2][2], xn[2][3]); o1.z = pack_bf16(xn[3][0], xn[3][1]); o1.w = pack_bf16(xn[3][2], xn[3][3]);
            *(u32x4*)xbr = o0; *(u32x4*)(xbr + 8) = o1; }
        else {
#pragma unroll
            for (int q = 0; q < 4; ++q) *(f32x4*)(xo + 4 * q) = xn[q]; }
        if (l + 1 < P.cfg.depth) {
            ss = wave_sum(ss); const float r = 1.0f / sqrtf(ss * (1.0f / DM) + 1e-6f);
            const float* nw = P.in[IN_NORM1_W] + (l + 1) * DM + lane * 16; const float* ad = ada_row(P, l + 1, s) + lane * 16; u32x4 o[2];
            f32x4 hvv[4];
#pragma unroll
            for (int q = 0; q < 4; ++q) { const f32x4 w = *(const f32x4*)(nw + 4 * q), sc = *(const f32x4*)(ad + 1024 + 4 * q), sh = *(const f32x4*)(ad + 4 * q); const f32x4 hv = xn[q] * r * w * (1.0f + sc) + sh; hvv[q] = hv;
                o[q >> 1][(q & 1) * 2] = pack_bf16(hv[0], hv[1]); o[q >> 1][(q & 1) * 2 + 1] = pack_bf16(hv[2], hv[3]); }
            bf16_t* hr = P.H + (size_t)tl * DM + lane * 16; *(u32x4*)hr = o[0]; *(u32x4*)(hr + 8) = o[1];
            float hmax = 0.f;
#pragma unroll
            for (int q = 0; q < 4; ++q) hmax = fmaxf(hmax, fmaxf(fmaxf(fabsf(hvv[q][0]), fabsf(hvv[q][1])), fmaxf(fabsf(hvv[q][2]), fabsf(hvv[q][3]))));
            hmax = wave_max_nn(hmax);
            const float hinv = hmax > 0.f ? 127.0f / hmax : 0.f; u32x4 qw;
#pragma unroll
            for (int q = 0; q < 4; ++q) qw[q] = ((unsigned)(int)rintf(hvv[q][0] * hinv) & 0xffu) | (((unsigned)(int)rintf(hvv[q][1] * hinv) & 0xffu) << 8) | (((unsigned)(int)rintf(hvv[q][2] * hinv) & 0xffu) << 16) | (((unsigned)(int)rintf(hvv[q][3] * hinv) & 0xffu) << 24);
            *(u32x4*)(P.HQ + (size_t)tl * DM + lane * 16) = qw; if (lane == 0) P.HS[tl] = hmax * (1.0f / 127.0f);
        }
    }
}
__device__ __forceinline__ void dev_hyena(const Params& P, int ck, int l, int order, LAS unsigned char* lds, int tid) {
    const int wave = tid >> 6, lane = tid & 63; const int L = P.cfg.ck_L[ck], nseq = P.cfg.ck_nseq[ck], li = P.cfg.ck_li[ck];
    const int XL = 2 * L + 32, ZL = L + 2 * HY_PAD; const int tps = L / 256, ntile = nseq * tps;
    LAS unsigned* R0 = (LAS unsigned*)lds; LAS unsigned* R1 = R0 + XL / 2 + 4; LAS unsigned short* ZP = (LAS unsigned short*)(R1 + XL / 2 + 4);
    for (int c = blockIdx.x; c < 256; c += gridDim.x) {
        __syncthreads();
        { const u32x4* g = (const u32x4*)(P.GT + gt_base(P, l, li, order * 256 + c)); u32x4 gr[3], zr[8];
#pragma unroll
          for (int k = 0; k < 3; ++k) { const int i = tid + k * NTHREADS_; gr[k] = g[i < XL / 8 ? i : 0]; }
#pragma unroll
          for (int sl = 0; sl < 8; ++sl) { const int slc = sl < nseq ? sl : nseq - 1; const bf16_t* z = order == 0 ? P.HYT + ((size_t)slc * 768 + c) * L : P.HYZ + ((size_t)slc * 256 + c) * L;
              zr[sl] = *(const u32x4*)(z + (tid < L / 8 ? tid : 0) * 8); }
#pragma unroll
          for (int k = 0; k < 3; ++k) { const int i = tid + k * NTHREADS_; if (i < XL / 8) ((LAS u32x4*)R0)[i] = gr[k]; }
          if (tid < 4) R0[XL / 2 + tid] = 0u;
#pragma unroll
          for (int sl = 0; sl < 8; ++sl) if (sl < nseq) { LAS unsigned short* zp = ZP + (size_t)sl * ZL;
              if (tid < L / 8) *(LAS u32x4*)(zp + HY_PAD + tid * 8) = zr[sl];
              for (int i = tid; i < HY_PAD / 8; i += NTHREADS_) { *(LAS u32x4*)(zp + i * 8) = (u32x4){0u, 0u, 0u, 0u}; *(LAS u32x4*)(zp + HY_PAD + L + i * 8) = (u32x4){0u, 0u, 0u, 0u}; } } }
        __syncthreads();
        for (int w = tid; w < XL / 2; w += NTHREADS_) R1[w] = (R0[w] >> 16) | (R0[w + 1] << 16);
        __syncthreads();
        const float skip = P.in[IN_HY_BIAS][(l * 2 + order) * 256 + c];
        const int ngrp = nseq / 4;
        for (int f = wave; f < (tps / 2) * ngrp; f += 8) {
            const int ct0 = (f % (tps / 2)) * 2, sg = f / (tps / 2); int m_lo, m_hi; hy_mrange(L, ct0, m_lo, m_hi);
            const LAS unsigned short* zp = ZP + (size_t)(sg * 4) * ZL + HY_PAD;
            f32x4 acc[2][4];
#pragma unroll
            for (int j = 0; j < 4; ++j) { acc[0][j] = (f32x4){0.f, 0.f, 0.f, 0.f}; acc[1][j] = (f32x4){0.f, 0.f, 0.f, 0.f}; }
            u32x2 gwp[2][4];
#pragma unroll
            for (int cc = 0; cc < 2; ++cc)
#pragma unroll
                for (int j = 0; j < 4; ++j) gwp[cc][j] = *(const u32x2*)(P.HYT + ((size_t)(sg * 4 + j) * 768 + (order == 0 ? 256 : 512) + c) * L + 256 * (ct0 + cc) + 16 * (lane & 15) + 4 * (lane >> 4));
            u32x4 na0, na1, nb[4];
#define HY_FRAGS(mm) do { const int x0_ = hy_afrag_x0(L, (mm), lane); const LAS unsigned* ab_ = (x0_ & 1) ? R1 + ((x0_ - 1) >> 1) : R0 + (x0_ >> 1); \
                na0.x = ab_[0]; na0.y = ab_[1]; na0.z = ab_[2]; na0.w = ab_[3]; na1.x = ab_[-128]; na1.y = ab_[-127]; na1.z = ab_[-126]; na1.w = ab_[-125]; \
                const int bp_ = hy_bfrag_pos(ct0, (mm), lane); _Pragma("unroll") for (int j = 0; j < 4; ++j) nb[j] = *(const LAS u32x4*)(zp + (size_t)j * ZL + bp_); } while (0)
            HY_FRAGS(m_lo);
#pragma unroll 2
            for (int m = m_lo; m <= m_hi; ++m) {
                const u32x4 a0 = na0, a1 = na1; u32x4 bq[4];
#pragma unroll
                for (int j = 0; j < 4; ++j) bq[j] = nb[j];
                HY_FRAGS(m < m_hi ? m + 1 : m_hi);
#pragma unroll
                for (int j = 0; j < 4; ++j) { const bf16x8 b = __builtin_bit_cast(bf16x8, bq[j]);
                    acc[0][j] = __builtin_amdgcn_mfma_f32_16x16x32_bf16(__builtin_bit_cast(bf16x8, a0), b, acc[0][j], 0, 0, 0);
                    acc[1][j] = __builtin_amdgcn_mfma_f32_16x16x32_bf16(__builtin_bit_cast(bf16x8, a1), b, acc[1][j], 0, 0, 0); }
            }
#undef HY_FRAGS
#pragma unroll
            for (int cc = 0; cc < 2; ++cc) {
                const int t = 256 * (ct0 + cc) + 16 * (lane & 15) + 4 * (lane >> 4);
#pragma unroll
                for (int j = 0; j < 4; ++j) { const int sl = sg * 4 + j;
                    const u32x2 zw = *(const LAS u32x2*)(zp + (size_t)j * ZL + t); const u32x2 gw = gwp[cc][j];
                    const float o0 = u2f(gw.x << 16) * (acc[cc][j][0] + u2f(zw.x << 16) * skip), o1 = u2f(gw.x & 0xffff0000u) * (acc[cc][j][1] + u2f(zw.x & 0xffff0000u) * skip);
                    const float o2 = u2f(gw.y << 16) * (acc[cc][j][2] + u2f(zw.y << 16) * skip), o3 = u2f(gw.y & 0xffff0000u) * (acc[cc][j][3] + u2f(zw.y & 0xffff0000u) * skip);
                    u32x2 ow; ow.x = pack_bf16(o0, o1); ow.y = pack_bf16(o2, o3);
                    bf16_t* dst = order == 0 ? P.HYZ + ((size_t)sl * 256 + c) * L + t : P.HYT + ((size_t)sl * 768 + c) * L + t;
                    *(u32x2*)dst = ow; }
            }
        }
    }
}
__device__ __forceinline__ void dev_cum(const Params& P, int ck, int l, int tid) {
    const int wave = tid >> 6, lane = tid & 63; const int L = P.cfg.ck_L[ck], nchunk = L / SCK, nseq = P.cfg.ck_nseq[ck]; const int nunit = 2 * 2 * nseq * nchunk * 4;
    for (int u = blockIdx.x * 8 + wave; u < nunit; u += gridDim.x * 8) {
        const int h = u & 3; const int c = (u >> 2) % nchunk; const int sl = ((u >> 2) / nchunk) % nseq; const int d = ((u >> 2) / nchunk / nseq) & 1; const int ty = (u >> 2) / nchunk / nseq / 2;
        const int jj = d ? SCK - 1 - lane : lane; float* cum = P.CUM + cum_idx(P, ty, d, sl, h, c * SCK, L);
        if (ty == 0) { cum[jj] = (float)(lane + 1) * ret_la(d, h); continue; }
        const float A = -expf(P.in[IN_SSM_A_LOG][l * 8 + d * 4 + h]); const float dtb = P.in[IN_SSM_DT_BIAS][l * 8 + d * 4 + h];
        const size_t tl = (size_t)sl * L + c * SCK + jj; const float dt = softplusf(P.DT[tl * 8 + d * 4 + h] + P.DT2[tl * 8 + d * 4 + h] + dtb);
        float v = dt * A;
#pragma unroll
        for (int o = 1; o < 64; o <<= 1) { const float t = __shfl_up(v, o); if (lane >= o) v += t; }
        cum[jj] = v; P.DTS[cum_idx(P, 0, d, sl, h, c * SCK, L) + jj] = dt;
    }
}
template <int TY> __device__ __forceinline__ void dev_scan_state(const Params& P, int ck, int l, int tid) {
    constexpr int N = TY ? 64 : 32, NT = N / 16;
    const int wave = tid >> 6, lane = tid & 63, lq = lane & 15, q4 = lane >> 4; const int L = P.cfg.ck_L[ck], nseq = P.cfg.ck_nseq[ck], nchunk = L / SCK; const int nunit = 2 * nseq * nchunk * 4;
    for (int u = blockIdx.x * 8 + wave; u < nunit; u += gridDim.x * 8) {
        const int h = u & 3, c = (u >> 2) % nchunk, sl = ((u >> 2) / nchunk) % nseq, d = (u >> 2) / nchunk / nseq; const int t0 = c * SCK;
        const float* cum = P.CUM + cum_idx(P, TY, d, sl, h, t0, L); const float* dts = P.DTS + cum_idx(P, 0, d, sl, h, t0, L); const float cref = cum[d ? 0 : SCK - 1];
        f32x4 acc[NT][4];
#pragma unroll
        for (int nt = 0; nt < NT; ++nt)
#pragma unroll
            for (int pt = 0; pt < 4; ++pt) acc[nt][pt] = (f32x4){0.f, 0.f, 0.f, 0.f};
#pragma unroll
        for (int ks = 0; ks < 2; ++ks) { const int j0 = ks * 32 + 8 * q4;
            float w[8]; { const f32x4 c0 = *(const f32x4*)(cum + j0), c1 = *(const f32x4*)(cum + j0 + 4);
#pragma unroll
                for (int jj = 0; jj < 4; ++jj) { w[jj] = fexpf(cref - c0[jj]); w[4 + jj] = fexpf(cref - c1[jj]); }
                if (TY) { const f32x4 d0 = *(const f32x4*)(dts + j0), d1 = *(const f32x4*)(dts + j0 + 4);
#pragma unroll
                    for (int jj = 0; jj < 4; ++jj) { w[jj] *= d0[jj]; w[4 + jj] *= d1[jj]; } }
                else {
#pragma unroll
                    for (int jj = 0; jj < 8; ++jj) w[jj] *= 0.17677669529663687f; } }
            bf16x8 bf[4], af[NT];
#pragma unroll
            for (int pt = 0; pt < 4; ++pt) { float v[8]; unpack8(*(const u32x4*)(sc_vT(P, TY, sl, h, pt * 16 + lq, L) + t0 + j0), v);
                u32x4 pw; pw.x = pack_bf16(v[0] * w[0], v[1] * w[1]); pw.y = pack_bf16(v[2] * w[2], v[3] * w[3]); pw.z = pack_bf16(v[4] * w[4], v[5] * w[5]); pw.w = pack_bf16(v[6] * w[6], v[7] * w[7]);
                bf[pt] = __builtin_bit_cast(bf16x8, pw); }
#pragma unroll
            for (int nt = 0; nt < NT; ++nt) af[nt] = *(const bf16x8*)(sc_kT(P, TY, sl, h, nt * 16 + lq, L) + t0 + j0);
#pragma unroll
            for (int nt = 0; nt < NT; ++nt)
#pragma unroll
                for (int pt = 0; pt < 4; ++pt) acc[nt][pt] = __builtin_amdgcn_mfma_f32_16x16x32_bf16(af[nt], bf[pt], acc[nt][pt], 0, 0, 0);
        }
        float* cs = (TY ? P.CSS : P.CSR) + (size_t)u * (N * 64);
#pragma unroll
        for (int nt = 0; nt < NT; ++nt)
#pragma unroll
            for (int pt = 0; pt < 4; ++pt) *(f32x4*)(cs + (pt * 16 + lq) * N + nt * 16 + 4 * q4) = acc[nt][pt];
    }
}
template <int TY> __device__ __forceinline__ void dev_scan_out(const Params& P, int ck, int l, int tid) {
    constexpr int N = TY ? 64 : 32, NK = N / 32;
    const int wave = tid >> 6, lane = tid & 63, lq = lane & 15, q4 = lane >> 4; const int L = P.cfg.ck_L[ck], nseq = P.cfg.ck_nseq[ck], nchunk = L / SCK;
    for (int wi = blockIdx.x; wi < nseq * nchunk; wi += gridDim.x) {
        const int sl = wi / nchunk, c = wi % nchunk, d = wave >> 2, h = wave & 3; const int u = (int)sc_unit(d, sl, c, h, nseq, nchunk); const int t0 = c * SCK; const size_t tl0 = (size_t)sl * L + t0;
        const float* cum = P.CUM + cum_idx(P, TY, d, sl, h, t0, L); const float* dts = P.DTS + cum_idx(P, 0, d, sl, h, t0, L);
        bf16x8 kf[4][NK], vf[4][2], hf[4][NK]; f32x4 cj[4], vs[4];
#pragma unroll
        for (int jt = 0; jt < 4; ++jt) {
#pragma unroll
            for (int ks = 0; ks < NK; ++ks) kf[jt][ks] = *(const bf16x8*)(sc_krow(P, TY, h, tl0 + jt * 16 + lq) + ks * 32 + 8 * q4);
            cj[jt] = *(const f32x4*)(cum + jt * 16 + 4 * q4);
            if (TY) vs[jt] = *(const f32x4*)(dts + jt * 16 + 4 * q4); else vs[jt] = (f32x4){0.17677669529663687f, 0.17677669529663687f, 0.17677669529663687f, 0.17677669529663687f}; }
        const bf16_t* hb = (TY ? P.HBS : P.HBR) + (size_t)u * (N * 64);
#pragma unroll
        for (int pt = 0; pt < 4; ++pt) { const bf16_t* vp = sc_vT(P, TY, sl, h, pt * 16 + lq, L) + t0 + 4 * q4;
#pragma unroll
            for (int kp = 0; kp < 2; ++kp) { const u32x2 lo = *(const u32x2*)(vp + kp * 32), hi = *(const u32x2*)(vp + kp * 32 + 16); vf[pt][kp] = __builtin_bit_cast(bf16x8, (u32x4){lo.x, lo.y, hi.x, hi.y}); }
#pragma unroll
            for (int ks = 0; ks < NK; ++ks) hf[pt][ks] = *(const bf16x8*)(hb + (pt * 16 + lq) * N + ks * 32 + 8 * q4); }
        bf16_t* Y = (bf16_t*)(TY ? P.SSDY : P.RETY) + (size_t)d * P.cfg.Tmax * 256;
#pragma unroll
        for (int it = 0; it < 4; ++it) {
            bf16x8 qf[NK];
#pragma unroll
            for (int ks = 0; ks < NK; ++ks) qf[ks] = *(const bf16x8*)(sc_qrow(P, TY, h, tl0 + it * 16 + lq) + ks * 32 + 8 * q4);
            const float ci = cum[it * 16 + lq];
            f32x4 y[4];
#pragma unroll
            for (int pt = 0; pt < 4; ++pt) y[pt] = (f32x4){0.f, 0.f, 0.f, 0.f};
#pragma unroll
            for (int kp = 0; kp < 2; ++kp) {
                if (d == 0 ? (2 * kp > it) : (2 * kp + 1 < it)) continue;
                float p[8];
#pragma unroll
                for (int e = 0; e < 2; ++e) { const int jt = 2 * kp + e;
                    f32x4 sacc = {0.f, 0.f, 0.f, 0.f};
#pragma unroll
                    for (int ks = 0; ks < NK; ++ks) sacc = __builtin_amdgcn_mfma_f32_16x16x32_bf16(kf[jt][ks], qf[ks], sacc, 0, 0, 0);
#pragma unroll
                    for (int r = 0; r < 4; ++r) { const int jj = jt * 16 + 4 * q4 + r, ii = it * 16 + lq; const bool keep = d == 0 ? (jj <= ii) : (jj >= ii);
                        p[4 * e + r] = keep ? sacc[r] * fexpf(ci - cj[jt][r]) * vs[jt][r] : 0.f; } }
                u32x4 pw; pw.x = pack_bf16(p[0], p[1]); pw.y = pack_bf16(p[2], p[3]); pw.z = pack_bf16(p[4], p[5]); pw.w = pack_bf16(p[6], p[7]);
                const bf16x8 pb = __builtin_bit_cast(bf16x8, pw);
#pragma unroll
                for (int pt = 0; pt < 4; ++pt) y[pt] = __builtin_amdgcn_mfma_f32_16x16x32_bf16(vf[pt][kp], pb, y[pt], 0, 0, 0);
            }
            { const float eci = fexpf(ci);
#pragma unroll
              for (int ks = 0; ks < NK; ++ks) { float qv[8]; unpack8(__builtin_bit_cast(u32x4, qf[ks]), qv);
                  u32x4 qw; qw.x = pack_bf16(qv[0] * eci, qv[1] * eci); qw.y = pack_bf16(qv[2] * eci, qv[3] * eci); qw.z = pack_bf16(qv[4] * eci, qv[5] * eci); qw.w = pack_bf16(qv[6] * eci, qv[7] * eci);
                  const bf16x8 qs = __builtin_bit_cast(bf16x8, qw);
#pragma unroll
                  for (int pt = 0; pt < 4; ++pt) y[pt] = __builtin_amdgcn_mfma_f32_16x16x32_bf16(hf[pt][ks], qs, y[pt], 0, 0, 0); } }
#pragma unroll
            for (int pt = 0; pt < 4; ++pt) { u32x2 o; o.x = pack_bf16(y[pt][0], y[pt][1]); o.y = pack_bf16(y[pt][2], y[pt][3]); *(u32x2*)(Y + (tl0 + it * 16 + lq) * 256 + h * 64 + pt * 16 + 4 * q4) = o; }
        }
    }
}
__device__ __forceinline__ void dev_scan_post(const Params& P, int ck, int l, int tid) {
    constexpr int NB = 8;
    const int wave = tid >> 6, lane = tid & 63; const int T = P.cfg.ck_nseq[ck] * P.cfg.ck_L[ck]; const int c4 = lane * 4; const size_t dstr = (size_t)P.cfg.Tmax * 256;
    const f32x4 wr = *(const f32x4*)(P.in[IN_RET_GN_W] + l * 256 + c4), ws = *(const f32x4*)(P.in[IN_SSM_NORM_W] + l * 256 + c4); const float Dh = P.in[IN_SSM_D][l * 4 + (lane >> 4)];
    const int L_ = P.cfg.ck_L[ck], nchunk_ = L_ / SCK; (void)T;
    for (int wi = blockIdx.x; wi < P.cfg.ck_nseq[ck] * nchunk_; wi += gridDim.x) {
        const size_t g = ((size_t)(wi / nchunk_) * L_ + (size_t)(wi % nchunk_) * SCK) / NB + wave;
        u32x2 ra[NB], rb[NB], rg[NB], sa[NB], sb[NB], sx[NB], sz[NB];
#pragma unroll
        for (int b = 0; b < NB; ++b) { const size_t tl = (size_t)g * NB + b;
            ra[b] = *(const u32x2*)((const bf16_t*)P.RETY + tl * 256 + c4); rb[b] = *(const u32x2*)((const bf16_t*)P.RETY + dstr + tl * 256 + c4); rg[b] = *(const u32x2*)(P.PROJ + tl * NPROJ + C_RG + c4);
            sa[b] = *(const u32x2*)((const bf16_t*)P.SSDY + tl * 256 + c4); sb[b] = *(const u32x2*)((const bf16_t*)P.SSDY + dstr + tl * 256 + c4); sx[b] = *(const u32x2*)(P.XBC + tl * 512 + c4); sz[b] = *(const u32x2*)(P.PROJ + tl * NPROJ + C_SZ + c4); }
#pragma unroll
        for (int b = 0; b < NB; ++b) { const size_t tl = (size_t)g * NB + b;
            { const u32x2 ya = ra[b], yb = rb[b], gw = rg[b];
              const f32x4 y = {u2f(ya.x << 16) + u2f(yb.x << 16), u2f(ya.x & 0xffff0000u) + u2f(yb.x & 0xffff0000u), u2f(ya.y << 16) + u2f(yb.y << 16), u2f(ya.y & 0xffff0000u) + u2f(yb.y & 0xffff0000u)};
              float ss = row_sum16(y[0] * y[0] + y[1] * y[1] + y[2] * y[2] + y[3] * y[3]);
              const float r = 1.0f / sqrtf(ss * (1.0f / 64.0f) + 1e-6f);
              const float g0 = siluf(u2f(gw.x << 16)), g1 = siluf(u2f(gw.x & 0xffff0000u)), g2 = siluf(u2f(gw.y << 16)), g3 = siluf(u2f(gw.y & 0xffff0000u));
              u32x2 o; o.x = pack_bf16(y[0] * r * wr[0] * g0, y[1] * r * wr[1] * g1); o.y = pack_bf16(y[2] * r * wr[2] * g2, y[3] * r * wr[3] * g3);
              *(u32x2*)(P.YS + tl * DM + 512 + c4) = o; }
            { const u32x2 ya = sa[b], yb = sb[b], xw = sx[b], zw = sz[b];
              f32x4 y = {u2f(ya.x << 16) + u2f(yb.x << 16), u2f(ya.x & 0xffff0000u) + u2f(yb.x & 0xffff0000u), u2f(ya.y << 16) + u2f(yb.y << 16), u2f(ya.y & 0xffff0000u) + u2f(yb.y & 0xffff0000u)};
              y[0] = (y[0] + Dh * u2f(xw.x << 16)) * siluf(u2f(zw.x << 16)); y[1] = (y[1] + Dh * u2f(xw.x & 0xffff0000u)) * siluf(u2f(zw.x & 0xffff0000u));
              y[2] = (y[2] + Dh * u2f(xw.y << 16)) * siluf(u2f(zw.y << 16)); y[3] = (y[3] + Dh * u2f(xw.y & 0xffff0000u)) * siluf(u2f(zw.y & 0xffff0000u));
              float ss = y[0] * y[0] + y[1] * y[1] + y[2] * y[2] + y[3] * y[3]; ss = wave_sum(ss);
              const float r = 1.0f / sqrtf(ss * (1.0f / 256.0f) + 1e-6f);
              u32x2 o; o.x = pack_bf16(y[0] * r * ws[0], y[1] * r * ws[1]); o.y = pack_bf16(y[2] * r * ws[2], y[3] * r * ws[3]);
              *(u32x2*)(P.YS + tl * DM + 768 + c4) = o; } }
    }
}

#define KEY_INSERT(v, x) do { _Pragma("unroll") for (int k_ = 15; k_ >= 1; --k_) v[k_] = __builtin_amdgcn_fmed3f(v[k_ - 1], v[k_], (x)); v[0] = fmaxf(v[0], (x)); } while (0)
#define KEY_MERGE_XOR(v, m) do { float ov_[16]; _Pragma("unroll") for (int k_ = 0; k_ < 16; ++k_) ov_[k_] = __shfl_xor(v[k_], m); \
        _Pragma("unroll") for (int k_ = 0; k_ < 16; ++k_) v[k_] = fmaxf(v[k_], ov_[15 - k_]); \
        _Pragma("unroll") for (int st_ = 8; st_ >= 1; st_ >>= 1) { _Pragma("unroll") for (int i_ = 0; i_ < 16; ++i_) { if ((i_ & st_) == 0) { const float hi_ = fmaxf(v[i_], v[i_ + st_]), lo_ = fminf(v[i_], v[i_ + st_]); v[i_] = hi_; v[i_ + st_] = lo_; } } } } while (0)
__device__ __forceinline__ void dev_peer_topk(const Params& P, int ck, int l, int tid) {
    const int wave = tid >> 6, lane = tid & 63, lq = lane & 15, q4 = lane >> 4; const int T = P.cfg.ck_nseq[ck] * P.cfg.ck_L[ck];
    pg8::StaticOrder SO; SO.init(T, 2048, gridDim.x, blockIdx.x); pg8::Unit un;
    for (int ui = 0; SO.next(ui, un); ++ui) {
        const int h = un.pn; const size_t tl0 = (size_t)un.pm * 256 + wave * 32;
        const unsigned qm0 = (unsigned)(-(int)(q4 == 0)), qm1 = (unsigned)(-(int)(q4 == 1)), qm2 = (unsigned)(-(int)(q4 == 2)), qm3 = (unsigned)(-(int)(q4 == 3));
        float v1[2][16], v2[2][16];
        bf16x8 qfa[2][2][4];
#pragma unroll
        for (int sub = 0; sub < 2; ++sub)
#pragma unroll
            for (int tt = 0; tt < 2; ++tt)
#pragma unroll
                for (int ks = 0; ks < 4; ++ks) qfa[sub][tt][ks] = *(const bf16x8*)(P.PROJ + (tl0 + tt * 16 + lq) * 2048 + (h * 2 + sub) * 128 + 8 * q4 + ks * 32);
#pragma unroll
        for (int sub = 0; sub < 2; ++sub) {
            const int hc = h * 2 + sub; const bf16_t* kb = P.keys_bf + ((size_t)l * 16 + hc) * 128 * 128;
            bf16x8 qf[2][4];
#pragma unroll
            for (int tt = 0; tt < 2; ++tt)
#pragma unroll
                for (int ks = 0; ks < 4; ++ks) qf[tt][ks] = qfa[sub][tt][ks];
            float v[2][16];
#pragma unroll
            for (int k = 0; k < 16; ++k) { v[0][k] = -3.0e38f; v[1][k] = -3.0e38f; }
            bf16x8 kfn[4];
#pragma unroll
            for (int ks = 0; ks < 4; ++ks) kfn[ks] = *(const bf16x8*)(kb + (size_t)lq * 128 + ks * 32 + 8 * q4);
#pragma unroll 1
            for (int kt = 0; kt < 8; ++kt) {
                f32x4 s0 = {0.f, 0.f, 0.f, 0.f}, s1 = {0.f, 0.f, 0.f, 0.f}; bf16x8 kfc[4]; const int ktn = kt < 7 ? kt + 1 : 7;
#pragma unroll
                for (int ks = 0; ks < 4; ++ks) { kfc[ks] = kfn[ks]; kfn[ks] = *(const bf16x8*)(kb + (size_t)(ktn * 16 + lq) * 128 + ks * 32 + 8 * q4); }
#pragma unroll
                for (int ks = 0; ks < 4; ++ks) { const bf16x8 kf = kfc[ks];
                    s0 = __builtin_amdgcn_mfma_f32_16x16x32_bf16(kf, qf[0][ks], s0, 0, 0, 0); s1 = __builtin_amdgcn_mfma_f32_16x16x32_bf16(kf, qf[1][ks], s1, 0, 0, 0); }
#pragma unroll
                for (int r = 0; r < 4; ++r) { const unsigned id = (unsigned)(kt * 16 + 4 * q4 + r); const float x0 = u2f((f2u(s0[r]) & ~0x7Fu) | id); KEY_INSERT(v[0], x0); }
                __builtin_amdgcn_sched_barrier(0);
#pragma unroll
                for (int r = 0; r < 4; ++r) { const unsigned id = (unsigned)(kt * 16 + 4 * q4 + r); const float x1 = u2f((f2u(s1[r]) & ~0x7Fu) | id); KEY_INSERT(v[1], x1); }
                __builtin_amdgcn_sched_barrier(0);
            }
#pragma unroll
            for (int tt = 0; tt < 2; ++tt) { KEY_MERGE_XOR(v[tt], 16); KEY_MERGE_XOR(v[tt], 32);
                if (sub == 0) {
#pragma unroll
                    for (int k = 0; k < 16; ++k) v1[tt][k] = v[tt][k]; }
                else {
#pragma unroll
                    for (int k = 0; k < 16; ++k) v2[tt][k] = v[tt][k]; } }
        }
#pragma unroll
        for (int tt = 0; tt < 2; ++tt) {
            float vt[16];
#pragma unroll
            for (int k = 0; k < 16; ++k) vt[k] = -3.0e38f;
            { float w1[16], w2[16];
#pragma unroll
              for (int k = 0; k < 16; ++k) { w1[k] = u2f(f2u(v1[tt][k]) & ~0x7Fu); w2[k] = u2f(f2u(v2[tt][k]) & ~0x7Fu); }
              { const float x = u2f((qm0 & ((f2u(w1[0] + w2[0]) & ~0xFFu) | 0u)) | (qm1 & ((f2u(w1[1] + w2[0]) & ~0xFFu) | 16u)) | (qm2 & ((f2u(w1[2] + w2[0]) & ~0xFFu) | 32u)) | (qm3 & ((f2u(w1[7] + w2[0]) & ~0xFFu) | 112u))); KEY_INSERT(vt, x); }
              { const float x = u2f((qm0 & ((f2u(w1[0] + w2[1]) & ~0xFFu) | 1u)) | (qm1 & ((f2u(w1[1] + w2[1]) & ~0xFFu) | 17u)) | (qm2 & ((f2u(w1[2] + w2[1]) & ~0xFFu) | 33u)) | (qm3 & ((f2u(w1[7] + w2[1]) & ~0xFFu) | 113u))); KEY_INSERT(vt, x); }
              { const float x = u2f((qm0 & ((f2u(w1[0] + w2[2]) & ~0xFFu) | 2u)) | (qm1 & ((f2u(w1[1] + w2[2]) & ~0xFFu) | 18u)) | (qm2 & ((f2u(w1[2] + w2[2]) & ~0xFFu) | 34u)) | (qm3 & ((f2u(w1[8] + w2[0]) & ~0xFFu) | 128u))); KEY_INSERT(vt, x); }
              { const float x = u2f((qm0 & ((f2u(w1[0] + w2[3]) & ~0xFFu) | 3u)) | (qm1 & ((f2u(w1[1] + w2[3]) & ~0xFFu) | 19u)) | (qm2 & ((f2u(w1[2] + w2[3]) & ~0xFFu) | 35u)) | (qm3 & ((f2u(w1[9] + w2[0]) & ~0xFFu) | 144u))); KEY_INSERT(vt, x); }
              { const float x = u2f((qm0 & ((f2u(w1[0] + w2[4]) & ~0xFFu) | 4u)) | (qm1 & ((f2u(w1[1] + w2[4]) & ~0xFFu) | 20u)) | (qm2 & ((f2u(w1[2] + w2[4]) & ~0xFFu) | 36u)) | (qm3 & ((f2u(w1[10] + w2[0]) & ~0xFFu) | 160u))); KEY_INSERT(vt, x); }
              { const float x = u2f((qm0 & ((f2u(w1[0] + w2[5]) & ~0xFFu) | 5u)) | (qm1 & ((f2u(w1[1] + w2[5]) & ~0xFFu) | 21u)) | (qm2 & ((f2u(w1[4] + w2[0]) & ~0xFFu) | 64u)) | (qm3 & ((f2u(w1[11] + w2[0]) & ~0xFFu) | 176u))); KEY_INSERT(vt, x); }
              { const float x = u2f((qm0 & ((f2u(w1[0] + w2[6]) & ~0xFFu) | 6u)) | (qm1 & ((f2u(w1[1] + w2[6]) & ~0xFFu) | 22u)) | (qm2 & ((f2u(w1[4] + w2[1]) & ~0xFFu) | 65u)) | (qm3 & ((f2u(w1[12] + w2[0]) & ~0xFFu) | 192u))); KEY_INSERT(vt, x); }
              { const float x = u2f((qm0 & ((f2u(w1[0] + w2[7]) & ~0xFFu) | 7u)) | (qm1 & ((f2u(w1[1] + w2[7]) & ~0xFFu) | 23u)) | (qm2 & ((f2u(w1[4] + w2[2]) & ~0xFFu) | 66u)) | (qm3 & ((f2u(w1[13] + w2[0]) & ~0xFFu) | 208u))); KEY_INSERT(vt, x); }
              { const float x = u2f((qm0 & ((f2u(w1[0] + w2[8]) & ~0xFFu) | 8u)) | (qm1 & ((f2u(w1[3] + w2[0]) & ~0xFFu) | 48u)) | (qm2 & ((f2u(w1[5] + w2[0]) & ~0xFFu) | 80u)) | (qm3 & ((f2u(w1[14] + w2[0]) & ~0xFFu) | 224u))); KEY_INSERT(vt, x); }
              { const float x = u2f((qm0 & ((f2u(w1[0] + w2[9]) & ~0xFFu) | 9u)) | (qm1 & ((f2u(w1[3] + w2[1]) & ~0xFFu) | 49u)) | (qm2 & ((f2u(w1[5] + w2[1]) & ~0xFFu) | 81u)) | (qm3 & ((f2u(w1[15] + w2[0]) & ~0xFFu) | 240u))); KEY_INSERT(vt, x); }
              { const float x = u2f((qm0 & ((f2u(w1[0] + w2[10]) & ~0xFFu) | 10u)) | (qm1 & ((f2u(w1[3] + w2[2]) & ~0xFFu) | 50u)) | (qm2 & ((f2u(w1[6] + w2[0]) & ~0xFFu) | 96u)) | (qm3 & 0xFF7FFFFFu)); KEY_INSERT(vt, x); }
              { const float x = u2f((qm0 & ((f2u(w1[0] + w2[11]) & ~0xFFu) | 11u)) | (qm1 & ((f2u(w1[3] + w2[3]) & ~0xFFu) | 51u)) | (qm2 & ((f2u(w1[6] + w2[1]) & ~0xFFu) | 97u)) | (qm3 & 0xFF7FFFFFu)); KEY_INSERT(vt, x); }
              { const float x = u2f((qm0 & ((f2u(w1[0] + w2[12]) & ~0xFFu) | 12u)) | (qm1 & 0xFF7FFFFFu) | (qm2 & 0xFF7FFFFFu) | (qm3 & 0xFF7FFFFFu)); KEY_INSERT(vt, x); }
              { const float x = u2f((qm0 & ((f2u(w1[0] + w2[13]) & ~0xFFu) | 13u)) | (qm1 & 0xFF7FFFFFu) | (qm2 & 0xFF7FFFFFu) | (qm3 & 0xFF7FFFFFu)); KEY_INSERT(vt, x); }
              { const float x = u2f((qm0 & ((f2u(w1[0] + w2[14]) & ~0xFFu) | 14u)) | (qm1 & 0xFF7FFFFFu) | (qm2 & 0xFF7FFFFFu) | (qm3 & 0xFF7FFFFFu)); KEY_INSERT(vt, x); }
              { const float x = u2f((qm0 & ((f2u(w1[0] + w2[15]) & ~0xFFu) | 15u)) | (qm1 & 0xFF7FFFFFu) | (qm2 & 0xFF7FFFFFu) | (qm3 & 0xFF7FFFFFu)); KEY_INSERT(vt, x); }
            }
            KEY_MERGE_XOR(vt, 16); KEY_MERGE_XOR(vt, 32);
            const float top = u2f(f2u(vt[0]) & ~0xFFu); float den = 0.f;
#pragma unroll
            for (int k = 0; k < 16; ++k) den += fexpf(u2f(f2u(vt[k]) & ~0xFFu) - top);
            const float rd = 1.0f / den; f32x4 gout; u32x4 iout;
#pragma unroll
            for (int r = 0; r < 4; ++r) { const unsigned kbits = (qm0 & f2u(vt[r])) | (qm1 & f2u(vt[4 + r])) | (qm2 & f2u(vt[8 + r])) | (qm3 & f2u(vt[12 + r])); const int a = (kbits >> 4) & 15, b = kbits & 15;
                unsigned ia = 0u, ib = 0u;
#pragma unroll
                for (int k = 0; k < 16; ++k) { ia |= (unsigned)(-(int)(a == k)) & f2u(v1[tt][k]); ib |= (unsigned)(-(int)(b == k)) & f2u(v2[tt][k]); }
                ia &= 0x7Fu; ib &= 0x7Fu;
                iout[r] = ia * 128u + ib; gout[r] = fexpf(u2f(kbits & ~0xFFu) - top) * rd; }
            *(f32x4*)(P.PG + (tl0 + tt * 16 + lq) * 128 + h * 16 + 4 * q4) = gout; *(u32x4*)(P.PIDX + (tl0 + tt * 16 + lq) * 128 + h * 16 + 4 * q4) = iout;
        }
    }
}
constexpr int AT_ST = 16384;
__device__ __forceinline__ void dev_attn(const Params& P, int ck, int l, LAS unsigned char* lds, int tid) {
    const int wave = __builtin_amdgcn_readfirstlane(tid >> 6), lane = tid & 63, lq = lane & 15, q4 = lane >> 4; const int L = P.cfg.ck_L[ck], nseq = P.cfg.ck_nseq[ck];
    const int nqb = L / 256, nunit = nseq * 4 * nqb, nkt = L / 64;
    const float lam = P.lam[l * 4 + 0], lam_init = P.lam[l * 4 + 1]; const float LOG2E = 1.4426950408889634f; const float Ms = P.lam[l * 4 + 2] * LOG2E;
    const int drow = wave * 8 + (lane >> 3), dch = (lane & 7) ^ (lane >> 3);
    for (int u0 = blockIdx.x; u0 < nunit; u0 += gridDim.x) {
        const int u = (nunit & 7) == 0 ? (u0 & 7) * (nunit >> 3) + (u0 >> 3) : u0;
        const int qb = u % nqb, head = (u / nqb) & 3, sl = u / (nqb * 4);
        const float nsl = -exp2f(-2.0f * (float)(head + 1)) * LOG2E;
        const char* ksrc = (const char*)(P.PROJ + ((size_t)sl * L + drow) * NPROJ + C_DAK + head * 64) + dch * 16;
        const char* vsrc = (const char*)(P.VT + ((size_t)sl * 256 + head * 64 + drow) * L) + dch * 16;
        bf16x8 qf[2][2];
#pragma unroll
        for (int qt = 0; qt < 2; ++qt)
#pragma unroll
            for (int sub = 0; sub < 2; ++sub) qf[qt][sub] = *(const bf16x8*)(P.PROJ + ((size_t)sl * L + qb * 256 + wave * 32 + qt * 16 + lq) * NPROJ + C_DAQ + head * 64 + sub * 32 + q4 * 8);
        f32x4 O[2][2][4]; float lsum[2][2];
#pragma unroll
        for (int qt = 0; qt < 2; ++qt)
#pragma unroll
            for (int sub = 0; sub < 2; ++sub) { lsum[qt][sub] = 0.f;
#pragma unroll
                for (int vt = 0; vt < 4; ++vt) O[qt][sub][vt] = (f32x4){0.f, 0.f, 0.f, 0.f}; }
#define AT_ISSUE(kt_) do { const int kk_ = (kt_) < nkt ? (kt_) : nkt - 1; LAS unsigned char* sb_ = lds + ((kt_) & 3) * AT_ST + wave * 1024; \
        __builtin_amdgcn_global_load_lds((const unsigned*)(ksrc + (size_t)kk_ * 64 * NPROJ * 2), (LAS unsigned*)sb_, 16, 0, 0); \
        __builtin_amdgcn_global_load_lds((const unsigned*)(vsrc + (size_t)kk_ * 128), (LAS unsigned*)(sb_ + 8192), 16, 0, 0); } while (0)
        __syncthreads();
        AT_ISSUE(0); AT_ISSUE(1); AT_ISSUE(2);
        for (int kt = 0; kt < nkt; ++kt) {
            asm volatile("s_waitcnt vmcnt(4) lgkmcnt(0)" ::: "memory");
            __builtin_amdgcn_s_barrier();
            asm volatile("" ::: "memory");
            AT_ISSUE(kt + 3);
            const LAS unsigned char* Kt = lds + (kt & 3) * AT_ST; const LAS unsigned char* Vt = Kt + 8192;
#pragma unroll
            for (int h32 = 0; h32 < 2; ++h32) {
                bf16x8 vf[4];
#pragma unroll
                for (int vt = 0; vt < 4; ++vt) { const int vd = vt * 16 + lq; const int c0 = h32 * 4 + (q4 >> 1); const LAS unsigned char* vr = Vt + vd * 128 + (q4 & 1) * 8;
                    const u32x2 lo = *(const LAS u32x2*)(vr + ((c0 ^ (vd & 7)) << 4)), hi = *(const LAS u32x2*)(vr + (((c0 + 2) ^ (vd & 7)) << 4)); vf[vt] = __builtin_bit_cast(bf16x8, (u32x4){lo.x, lo.y, hi.x, hi.y}); }
                bf16x8 kf[2][2];
#pragma unroll
                for (int sub = 0; sub < 2; ++sub)
#pragma unroll
                    for (int kk = 0; kk < 2; ++kk) { const int r = h32 * 32 + kk * 16 + lq; kf[sub][kk] = *(const LAS bf16x8*)(Kt + r * 128 + (((sub * 4 + q4) ^ (r & 7)) << 4)); }
#pragma unroll
                for (int qt = 0; qt < 2; ++qt) {
                    const float rel = (float)(kt * 64 + h32 * 32 + 4 * q4 - (qb * 256 + wave * 32 + qt * 16 + lq));
                    float bias[8];
#pragma unroll
                    for (int r = 0; r < 4; ++r) { bias[r] = fabsf(rel + (float)r) * nsl - Ms; bias[4 + r] = fabsf(rel + (float)(16 + r)) * nsl - Ms; }
#pragma unroll
                    for (int sub = 0; sub < 2; ++sub) {
                        const f32x4 bz0 = {bias[0], bias[1], bias[2], bias[3]}, bz1 = {bias[4], bias[5], bias[6], bias[7]};
                        const f32x4 s0 = __builtin_amdgcn_mfma_f32_16x16x32_bf16(kf[sub][0], qf[qt][sub], bz0, 0, 0, 0), s1 = __builtin_amdgcn_mfma_f32_16x16x32_bf16(kf[sub][1], qf[qt][sub], bz1, 0, 0, 0);
                        float p[8];
#pragma unroll
                        for (int r = 0; r < 4; ++r) { p[r] = __builtin_amdgcn_exp2f(s0[r]); p[4 + r] = __builtin_amdgcn_exp2f(s1[r]); }
                        lsum[qt][sub] += ((p[0] + p[1]) + (p[2] + p[3])) + ((p[4] + p[5]) + (p[6] + p[7]));
                        u32x4 pw; pw.x = pack_bf16(p[0], p[1]); pw.y = pack_bf16(p[2], p[3]); pw.z = pack_bf16(p[4], p[5]); pw.w = pack_bf16(p[6], p[7]);
                        const bf16x8 pb = __builtin_bit_cast(bf16x8, pw);
#pragma unroll
                        for (int vt = 0; vt < 4; ++vt) O[qt][sub][vt] = __builtin_amdgcn_mfma_f32_16x16x32_bf16(vf[vt], pb, O[qt][sub][vt], 0, 0, 0);
                    }
                }
            }
        }
        asm volatile("s_waitcnt vmcnt(0)" ::: "memory");
#undef AT_ISSUE
#pragma unroll
        for (int qt = 0; qt < 2; ++qt) {
            float l1 = lsum[qt][0], l2 = lsum[qt][1];
            l1 += __shfl_xor(l1, 16); l1 += __shfl_xor(l1, 32); l2 += __shfl_xor(l2, 16); l2 += __shfl_xor(l2, 32);
            const float r1 = 1.0f / l1, r2 = lam / l2; float ss = 0.f; f32x4 o[4];
#pragma unroll
            for (int vt = 0; vt < 4; ++vt) { o[vt] = O[qt][0][vt] * r1 - O[qt][1][vt] * r2; ss += o[vt][0] * o[vt][0] + o[vt][1] * o[vt][1] + o[vt][2] * o[vt][2] + o[vt][3] * o[vt][3]; }
            ss += __shfl_xor(ss, 16); ss += __shfl_xor(ss, 32);
            const float rn = (1.0f / sqrtf(ss * (1.0f / 64.0f) + 1e-6f)) * (1.0f - lam_init);
            const size_t tl = (size_t)sl * L + qb * 256 + wave * 32 + qt * 16 + lq;
#pragma unroll
            for (int vt = 0; vt < 4; ++vt) { const int vd = vt * 16 + 4 * q4; const f32x4 w = *(const f32x4*)(P.in[IN_DA_SUBLN_W] + l * 256 + head * 64 + vd);
                u32x2 ow; ow.x = pack_bf16(o[vt][0] * rn * w[0], o[vt][1] * rn * w[1]); ow.y = pack_bf16(o[vt][2] * rn * w[2], o[vt][3] * rn * w[3]);
                *(u32x2*)(P.YS + tl * DM + 256 + head * 64 + vd) = ow; }
        }
    }
}
constexpr int TILE_LD = 72;
__device__ __forceinline__ void tile_put_col8(LAS unsigned short* tile, int t, int cg, const float* v) {
#pragma unroll
    for (int j = 0; j < 8; ++j) tile[(cg * 8 + j) * TILE_LD + t] = f2bf(v[j]);
}
__device__ __forceinline__ void tile_put_col8_raw(LAS unsigned short* tile, int t, int cg, const u32x4 w) {
    tile[(cg * 8 + 0) * TILE_LD + t] = (unsigned short)(w.x & 0xffffu); tile[(cg * 8 + 1) * TILE_LD + t] = (unsigned short)(w.x >> 16);
    tile[(cg * 8 + 2) * TILE_LD + t] = (unsigned short)(w.y & 0xffffu); tile[(cg * 8 + 3) * TILE_LD + t] = (unsigned short)(w.y >> 16);
    tile[(cg * 8 + 4) * TILE_LD + t] = (unsigned short)(w.z & 0xffffu); tile[(cg * 8 + 5) * TILE_LD + t] = (unsigned short)(w.z >> 16);
    tile[(cg * 8 + 6) * TILE_LD + t] = (unsigned short)(w.w & 0xffffu); tile[(cg * 8 + 7) * TILE_LD + t] = (unsigned short)(w.w >> 16);
}
constexpr int TNB = 4, TILE_SZ = 64 * TILE_LD;
__device__ __forceinline__ u32x4 sel0(const bool keep, const u32x4 w) { u32x4 r; r.x = keep ? w.x : 0u; r.y = keep ? w.y : 0u; r.z = keep ? w.z : 0u; r.w = keep ? w.w : 0u; return r; }
__device__ __forceinline__ void dev_pre_tiles(const Params& P, int ck, int l, LAS unsigned short* tile, int tid) {
    const int L = P.cfg.ck_L[ck], T = P.cfg.ck_nseq[ck] * L; const int tq = tid >> 3, g8 = tid & 7; const int ngrp = (T / 64 / TNB) * 16;
    for (int u = blockIdx.x; u < ngrp; u += gridDim.x) {
        const int ctile = u & 15, tg = u >> 4; const int tlb = tg * TNB * 64, sl = tlb / L, tb = tlb % L;
        if (ctile < 12) { const int c = ctile * 64 + g8 * 8; const float* w = P.in[IN_HY_CONV_W] + (size_t)l * 3 * 768 + c; const float* bb = P.in[IN_HY_CONV_B] + l * 768 + c;
            u32x4 r0[TNB], r1[TNB], r2[TNB];
#pragma unroll
            for (int b = 0; b < TNB; ++b) { const int t = tb + b * 64 + tq; const bf16_t* p = P.PROJ + (size_t)(tlb + b * 64 + tq) * NPROJ + C_HY + c;
                r1[b] = *(const u32x4*)p; r0[b] = *(const u32x4*)(p - (t > 0 ? NPROJ : 0)); r2[b] = *(const u32x4*)(p + (t + 1 < L ? NPROJ : 0)); }
            const f32x4 b0 = *(const f32x4*)bb, b1 = *(const f32x4*)(bb + 4), wa0 = *(const f32x4*)w, wa1 = *(const f32x4*)(w + 4), wb0 = *(const f32x4*)(w + 768), wb1 = *(const f32x4*)(w + 772), wc0 = *(const f32x4*)(w + 1536), wc1 = *(const f32x4*)(w + 1540);
#pragma unroll
            for (int b = 0; b < TNB; ++b) { const int t = tb + b * 64 + tq; float x0[8], x1[8], x2[8], acc[8];
                unpack8(sel0(t > 0, r0[b]), x0); unpack8(r1[b], x1); unpack8(sel0(t + 1 < L, r2[b]), x2);
#pragma unroll
                for (int j = 0; j < 4; ++j) { acc[j] = b0[j] + wb0[j] * x1[j] + wa0[j] * x0[j] + wc0[j] * x2[j]; acc[4 + j] = b1[j] + wb1[j] * x1[4 + j] + wa1[j] * x0[4 + j] + wc1[j] * x2[4 + j]; }
                tile_put_col8(tile + b * TILE_SZ, tq, g8, acc); }
        } else { u32x4 r[TNB];
#pragma unroll
            for (int b = 0; b < TNB; ++b) r[b] = *(const u32x4*)(P.PROJ + (size_t)(tlb + b * 64 + tq) * NPROJ + C_DAV + (ctile - 12) * 64 + g8 * 8);
#pragma unroll
            for (int b = 0; b < TNB; ++b) tile_put_col8_raw(tile + b * TILE_SZ, tq, g8, r[b]); }
        __syncthreads();
        bf16_t* dst = ctile < 12 ? P.HYT + ((size_t)sl * 768 + ctile * 64 + tq) * L + tb + g8 * 8 : P.VT + ((size_t)sl * 256 + (ctile - 12) * 64 + tq) * L + tb + g8 * 8;
#pragma unroll
        for (int b = 0; b < TNB; ++b) *(u32x4*)(dst + b * 64) = *(const LAS u32x4*)(tile + b * TILE_SZ + tq * TILE_LD + g8 * 8);
        __syncthreads();
    }
}
__device__ __forceinline__ void dev_scan_tiles(const Params& P, int ck, int l, LAS unsigned short* tile, int tid) {
    const int L = P.cfg.ck_L[ck], T = P.cfg.ck_nseq[ck] * L; const int tq = tid >> 3, g8 = tid & 7; const int ngrp = (T / 64 / TNB) * 14;
    for (int u = blockIdx.x; u < ngrp; u += gridDim.x) {
        const int ctile = u % 14, tg = u / 14; const int tlb = tg * TNB * 64, sl = tlb / L, tb = tlb % L;
        if (ctile < 6) { const int col = ctile < 2 ? C_RK + ctile * 64 + g8 * 8 : C_RV + (ctile - 2) * 64 + g8 * 8; u32x4 r[TNB];
#pragma unroll
            for (int b = 0; b < TNB; ++b) r[b] = *(const u32x4*)(P.PROJ + (size_t)(tlb + b * 64 + tq) * NPROJ + col);
#pragma unroll
            for (int b = 0; b < TNB; ++b) tile_put_col8_raw(tile + b * TILE_SZ, tq, g8, r[b]); }
        else { const int c = (ctile - 6) * 64 + g8 * 8; const float* w = P.in[IN_SSM_CONV_W] + (size_t)l * 5 * 512 + c; const float* bb = P.in[IN_SSM_CONV_B] + l * 512 + c;
            u32x4 r[TNB][5];
#pragma unroll
            for (int b = 0; b < TNB; ++b) { const int t = tb + b * 64 + tq; const bf16_t* p = P.PROJ + (size_t)(tlb + b * 64 + tq) * NPROJ + C_SXBC + c;
#pragma unroll
                for (int k = 0; k < 5; ++k) { const int tt2 = t + k - 2; r[b][k] = *(const u32x4*)(p + ((tt2 >= 0 && tt2 < L) ? (k - 2) * NPROJ : 0)); } }
            const f32x4 b0 = *(const f32x4*)bb, b1 = *(const f32x4*)(bb + 4);
#pragma unroll
            for (int b = 0; b < TNB; ++b) { const int t = tb + b * 64 + tq; float acc[8];
#pragma unroll
                for (int j = 0; j < 4; ++j) { acc[j] = b0[j]; acc[4 + j] = b1[j]; }
#pragma unroll
                for (int k = 0; k < 5; ++k) { const int tt2 = t + k - 2; float x[8]; unpack8(sel0(tt2 >= 0 && tt2 < L, r[b][k]), x); const f32x4 w0 = *(const f32x4*)(w + k * 512), w1 = *(const f32x4*)(w + k * 512 + 4);
#pragma unroll
                    for (int j = 0; j < 4; ++j) { acc[j] += w0[j] * x[j]; acc[4 + j] += w1[j] * x[4 + j]; } }
#pragma unroll
                for (int j = 0; j < 8; ++j) acc[j] = siluf(acc[j]);
                u32x4 o; o.x = pack_bf16(acc[0], acc[1]); o.y = pack_bf16(acc[2], acc[3]); o.z = pack_bf16(acc[4], acc[5]); o.w = pack_bf16(acc[6], acc[7]);
                *(u32x4*)(P.XBC + (size_t)(tlb + b * 64 + tq) * 512 + c) = o;
                if (ctile < 12) tile_put_col8_raw(tile + b * TILE_SZ, tq, g8, o); } }
        __syncthreads();
        if (ctile < 12) { bf16_t* dst = ctile < 2 ? P.RKT + ((size_t)sl * 128 + ctile * 64 + tq) * L : ctile < 6 ? P.RVT + ((size_t)sl * 256 + (ctile - 2) * 64 + tq) * L : P.XT + ((size_t)sl * 384 + (ctile - 6) * 64 + tq) * L;
#pragma unroll
            for (int b = 0; b < TNB; ++b) *(u32x4*)(dst + tb + b * 64 + g8 * 8) = *(const LAS u32x4*)(tile + b * TILE_SZ + tq * TILE_LD + g8 * 8); }
        __syncthreads();
    }
}
__device__ __forceinline__ void dev_hyout_tiles(const Params& P, int ck, LAS unsigned short* tile, int tid) {
    const int L = P.cfg.ck_L[ck], T = P.cfg.ck_nseq[ck] * L; const int tq = tid >> 3, g8 = tid & 7; const int ngrp = (T / 64 / TNB) * 4;
    for (int u = blockIdx.x; u < ngrp; u += gridDim.x) {
        const int ctile = u & 3, tg = u >> 2; const int tlb = tg * TNB * 64, sl = tlb / L, tb = tlb % L; u32x4 r[TNB];
#pragma unroll
        for (int b = 0; b < TNB; ++b) r[b] = *(const u32x4*)(P.HYT + ((size_t)sl * 768 + ctile * 64 + tq) * L + tb + b * 64 + g8 * 8);
#pragma unroll
        for (int b = 0; b < TNB; ++b) tile_put_col8_raw(tile + b * TILE_SZ, tq, g8, r[b]);
        __syncthreads();
#pragma unroll
        for (int b = 0; b < TNB; ++b) *(u32x4*)(P.YS + (size_t)(tlb + b * 64 + tq) * DM + ctile * 64 + g8 * 8) = *(const LAS u32x4*)(tile + b * TILE_SZ + tq * TILE_LD + g8 * 8);
        __syncthreads();
    }
}
__device__ __forceinline__ void dev_transpose_tile(const float* src, int ld_src, bf16_t* dst, int ld_dst, int r0, int c0, LAS float* tile, int tid) {
    const int tx = tid & 63, ty = tid >> 6;
#pragma unroll
    for (int i = 0; i < 8; ++i) tile[(ty + 8 * i) * 65 + tx] = src[(size_t)(r0 + ty + 8 * i) * ld_src + c0 + tx];
    __syncthreads();
#pragma unroll
    for (int i = 0; i < 8; ++i) dst[(size_t)(c0 + ty + 8 * i) * ld_dst + r0 + tx] = f2bf(tile[tx * 65 + ty + 8 * i]);
    __syncthreads();
}
__device__ __forceinline__ void dev_gt(const Params& P, long gtid, long gstride) {
    constexpr int NCH = 32;
    for (long w = gtid; w < (long)P.cfg.depth * 2 * 512 * NCH; w += gstride) {
        const int oc = w & 511, ch = (w >> 9) % NCH; const int lli = (int)((w >> 9) / NCH); const int l = lli >> 1, li = lli & 1;
        const int L = P.cfg.L_len[li]; const int ngx = (2 * L + 32) / 16, xpc = (ngx + NCH - 1) / NCH; const int xg0 = ch * xpc, xg1 = (xg0 + xpc) < ngx ? (xg0 + xpc) : ngx;
        const int o = oc >> 8, c = oc & 255;
        const float* fs = P.fsum + (size_t)lli * 65536 + o * 512 + c; float ssf = 0.f, ssb = 0.f;
#pragma unroll 16
        for (int k = 0; k < 64; ++k) { ssf += fs[k * 1024]; ssb += fs[k * 1024 + 256]; }
        const float scf = 1.0f / sqrtf(ssf + 1e-6f), scb = 1.0f / sqrtf(ssb + 1e-6f);
        bf16_t* row = P.GT + gt_base(P, l, li, oc);
#pragma unroll 2
        for (int xg = xg0; xg < xg1; ++xg) {
            const int x0 = xg * 16, d0 = L + 15 - x0; const bool fwd = d0 >= 15; const float sc = fwd ? scf : scb;
            const float* f = P.filt + filt_base(P, l, li) + o * 512 + (fwd ? 0 : 256) + c;
            float v[16];
#pragma unroll
            for (int j = 0; j < 16; ++j) { const int d = d0 - j; const int ad = d >= 0 ? d : -d; const float fv = f[(size_t)(ad < L ? ad : 0) * 1024]; v[j] = ad < L ? fv * sc : 0.f; }
            u32x4 w0, w1;
            w0.x = pack_bf16(v[0], v[1]); w0.y = pack_bf16(v[2], v[3]); w0.z = pack_bf16(v[4], v[5]); w0.w = pack_bf16(v[6], v[7]);
            w1.x = pack_bf16(v[8], v[9]); w1.y = pack_bf16(v[10], v[11]); w1.z = pack_bf16(v[12], v[13]); w1.w = pack_bf16(v[14], v[15]);
            *(u32x4*)(row + x0) = w0; *(u32x4*)(row + x0 + 8) = w1;
        }
    }
}
__device__ __forceinline__ void dev_filt(const Params& P, int tid) {
    const int wave = tid >> 6, lane = tid & 63; const int L0 = P.cfg.L_len[0], L1 = P.cfg.L_len[1], Lmax = P.cfg.Lmax;
    const int n0 = L0 / 8 * 4, per_l = (L0 + L1) / 8 * 4; const int n = P.cfg.depth * per_l;
    for (int wi0 = blockIdx.x * 8 + wave; wi0 < n; wi0 += gridDim.x * 8) {
        const int wi = __builtin_amdgcn_readfirstlane(wi0);
        const int l = wi / per_l, r = wi % per_l; const int li = r >= n0 ? 1 : 0; const int r2 = li ? r - n0 : r; const int cq = r2 & 3, pos0 = (r2 >> 2) * 8; const int L = li ? L1 : L0;
        const long pr0 = (long)(l * 2 + li) * Lmax + pos0;
        const float* hp = P.hid2 + (pr0 + (lane >> 3)) * 64 + (lane & 7) * 8;
        const u32x4 h0 = *(const u32x4*)hp, h1 = *(const u32x4*)(hp + 4);
        int hreg[8]; hreg[0] = (int)h0.x; hreg[1] = (int)h0.y; hreg[2] = (int)h0.z; hreg[3] = (int)h0.w; hreg[4] = (int)h1.x; hreg[5] = (int)h1.y; hreg[6] = (int)h1.z; hreg[7] = (int)h1.w;
        const int c4 = cq * 64 + lane; const float* w3 = P.in[IN_HF_W3] + (size_t)l * 64 * 1024 + c4 * 4;
        f32x4 acc[8], wn[8];
#pragma unroll
        for (int p = 0; p < 8; ++p) acc[p] = (f32x4){0.f, 0.f, 0.f, 0.f};
#pragma unroll
        for (int e = 0; e < 8; ++e) wn[e] = *(const f32x4*)(w3 + e * 1024);
#pragma unroll 1
        for (int jo = 0; jo < 8; ++jo) {
            f32x4 w[8]; const int jn = jo < 7 ? jo + 1 : 7;
#pragma unroll
            for (int e = 0; e < 8; ++e) { w[e] = wn[e]; wn[e] = *(const f32x4*)(w3 + (jn * 8 + e) * 1024); }
#pragma unroll
            for (int e = 0; e < 8; ++e)
#pragma unroll
                for (int p = 0; p < 8; ++p) { const float sv = __builtin_bit_cast(float, __builtin_amdgcn_readlane(hreg[e], p * 8 + jo)); acc[p] += w[e] * sv; }
        }
        const float mn = -3.0701134573253945f, mx = -15.350567286626972f;
        float delta[4];
#pragma unroll
        for (int e = 0; e < 4; ++e) delta[e] = fabsf(mn + (float)((c4 * 4 + e) & 255) * ((mx - mn) / 255.0f));
        float* fo = P.filt + filt_base(P, l, li) + (size_t)pos0 * 1024 + c4 * 4;
#pragma unroll
        for (int p = 0; p < 8; ++p) { const float t = (float)(pos0 + p) / (float)(L - 1); f32x4 o;
#pragma unroll
            for (int e = 0; e < 4; ++e) o[e] = acc[p][e] * fexpf(-t * delta[e]);
            *(f32x4*)(fo + (size_t)p * 1024) = o; }
    }
}
__device__ __forceinline__ void dev_ada(const Params& P, LAS float* lds, int tid) {
    constexpr int SH = 12;
    const int wave = tid >> 6, lane = tid & 63; const int ns = P.cfg.nseq_total, nh = (ns + SH - 1) / SH;
    for (int i = tid; i < ns * 256; i += NTHREADS) *(LAS f32x4*)(lds + 4 * i) = *(const f32x4*)(P.silu_c + 4 * i);
    __syncthreads();
    LAS float* red = lds + 24 * 1024;
    const int nitem = P.cfg.depth * 96 * nh;
    for (int it = blockIdx.x; it < nitem; it += gridDim.x) {
        const int half = it % nh, jb = (it / nh) % 96, l = it / (nh * 96); const int s0 = half * SH;
        const float* w = P.in[IN_ADA_W] + ((size_t)l * DM + wave * 128) * 6144 + jb * 64 + lane;
        float acc[SH];
#pragma unroll
        for (int q = 0; q < SH; ++q) acc[q] = 0.f;
#pragma unroll 1
        for (int k0 = 0; k0 < 128; k0 += 16) { float wv[16];
#pragma unroll
            for (int e = 0; e < 16; ++e) wv[e] = w[(size_t)(k0 + e) * 6144];
#pragma unroll
            for (int e4 = 0; e4 < 4; ++e4) {
#pragma unroll
                for (int q = 0; q < SH; ++q) { const int sq = (s0 + q < ns) ? s0 + q : ns - 1; const f32x4 cv = *(const LAS f32x4*)(lds + sq * 1024 + wave * 128 + k0 + 4 * e4);
                    acc[q] += cv[0] * wv[4 * e4] + cv[1] * wv[4 * e4 + 1] + cv[2] * wv[4 * e4 + 2] + cv[3] * wv[4 * e4 + 3]; }
                __builtin_amdgcn_sched_barrier(0); } }
#pragma unroll
        for (int q = 0; q < SH; ++q) red[(wave * SH + q) * 64 + lane] = acc[q];
        __syncthreads();
        for (int o = tid; o < SH * 64; o += NTHREADS) { const int q = o >> 6, j = o & 63; float v = 0.f;
#pragma unroll
            for (int wv_ = 0; wv_ < 8; ++wv_) v += red[(wv_ * SH + q) * 64 + j];
            if (s0 + q < ns) P.ada[((size_t)l * ns + s0 + q) * 6144 + jb * 64 + j] = v + P.in[IN_ADA_B][l * 6144 + jb * 64 + j]; }
        __syncthreads();
    }
}
struct WTile { const float* src; bf16_t* dst; int ld_src, ld_dst; };
__device__ __forceinline__ WTile wtile_of(const Params& P, int t) {
    const int per_layer = 2816; const int l = t / per_layer; int u = t % per_layer; WTile w; int r0, c0;
    if (u < 768) { w.src = P.in[IN_W_IN] + (size_t)l * DM * NIN; w.ld_src = NIN; w.dst = P.wcat_t + (size_t)l * NCAT * DM; w.ld_dst = DM; r0 = (u / 48) * 64; c0 = (u % 48) * 64; }
    else if (u < 1792) { u -= 768; const int i = u >> 8, v = u & 255; w.src = P.in[IN_W_GATE] + ((size_t)l * 4 + i) * DM * DM; w.ld_src = DM; w.dst = P.wcat_t + ((size_t)l * NCAT + NPROJ + i * 1024) * DM; w.ld_dst = DM; r0 = (v >> 4) * 64; c0 = (v & 15) * 64; }
    else if (u < 2048) { u -= 1792; const int i = u >> 6, v = u & 63; w.src = P.in[IN_W_BRANCH] + ((size_t)l * 4 + i) * 256 * DM; w.ld_src = DM; w.dst = P.wbr_t + ((size_t)l * 4096 + i * 1024) * 256; w.ld_dst = 256; r0 = (v >> 4) * 64; c0 = (v & 15) * 64; }
    else if (u < 2304) { u -= 2048; w.src = P.in[IN_W_OUT] + (size_t)l * DM * DM; w.ld_src = DM; w.dst = P.wout_t + (size_t)l * DM * DM; w.ld_dst = DM; r0 = (u >> 4) * 64; c0 = (u & 15) * 64; }
    else { u -= 2304; w.src = P.in[IN_PEER_WQ] + (size_t)l * DM * 2048; w.ld_src = 2048; w.dst = P.wq_t + (size_t)l * 2048 * DM; w.ld_dst = DM; r0 = (u >> 5) * 64; c0 = (u & 31) * 64; }
    w.src += (size_t)r0 * w.ld_src + c0; w.dst += (size_t)c0 * w.ld_dst + r0;
    return w;
}
__device__ __forceinline__ void dev_prologue_weights(const Params& P, LAS float* tile, int tid) {
    constexpr int WB = 4, WT = 64 * 65;
    const int total = P.cfg.depth * 2816; const int tx = tid & 63, ty = tid >> 6;
    for (int t0 = blockIdx.x; t0 < total; t0 += gridDim.x * WB) {
        float v[WB][8];
#pragma unroll
        for (int b = 0; b < WB; ++b) { const int t = t0 + b * gridDim.x; if (t < total) { const WTile w = wtile_of(P, t);
#pragma unroll
                for (int i = 0; i < 8; ++i) v[b][i] = w.src[(size_t)(ty + 8 * i) * w.ld_src + tx]; } }
#pragma unroll
        for (int b = 0; b < WB; ++b)
#pragma unroll
            for (int i = 0; i < 8; ++i) tile[b * WT + (ty + 8 * i) * 65 + tx] = v[b][i];
        __syncthreads();
#pragma unroll
        for (int b = 0; b < WB; ++b) { const int t = t0 + b * gridDim.x; if (t < total) { const WTile w = wtile_of(P, t);
#pragma unroll
                for (int i = 0; i < 8; ++i) w.dst[(size_t)(ty + 8 * i) * w.ld_dst + tx] = f2bf(tile[b * WT + tx * 65 + ty + 8 * i]); } }
        __syncthreads();
    }
}
#endif

constexpr int LDS_BYTES = pg8::STAGE_BYTES + 256;

#if DEV_CODE || !defined(HOST_TEST)
typedef const __attribute__((address_space(4))) Params* KParams;
__device__ __forceinline__ const Params* launder(KParams p) { asm volatile("" : "+s"(p)); return (const Params*)p; }
__global__ void __launch_bounds__(NTHREADS, 2) fwd_kernel(Params P_arg) {
    const KParams Pk = (KParams)__builtin_amdgcn_kernarg_segment_ptr();
    extern __shared__ __attribute__((aligned(16))) unsigned char lds[];
    const int tid = threadIdx.x;
    const int wbase_ = __builtin_amdgcn_readfirstlane(tid & ~63);
    volatile LAS unsigned* xbw = (volatile LAS unsigned*)((LAS unsigned char*)lds + pg8::STAGE_BYTES);
    if (tid < 4) xbw[tid] = 0u;
    __syncthreads();
    int pb, pe, n_chunks, depth;
    { const Params& P = *launder(Pk); pb = P.pb; pe = P.pe; n_chunks = P.cfg.n_chunks; depth = P.cfg.depth;
      if (pe - pb > 1) { XcdBarrier bar = xcd_barrier_post(P.ctl, xbw); xcd_barrier<true>(bar); } }
    int ctr = 0;
#ifndef STAGE_MASK
#define STAGE_MASK 0xFFFFFFFFu
#endif
#define STAGE_BEGIN(sid) if (((STAGE_MASK >> (sid)) & 1u) && ctr >= pb && ctr < pe) { const Params& P = *launder(Pk); const Cfg& cf = P.cfg; (void)cf; int tid_; asm volatile("v_mbcnt_lo_u32_b32 %0, -1, 0\n\tv_mbcnt_hi_u32_b32 %0, -1, %0\n\tv_add_u32 %0, %1, %0" : "=&v"(tid_) : "s"(wbase_)); const long gtid = (long)blockIdx.x * NTHREADS + tid_; const long gstride = (long)gridDim.x * NTHREADS; (void)gtid; (void)gstride;
#define STAGE_BEGIN_C(sid) STAGE_BEGIN(sid) const int T = cf.ck_nseq[ck] * cf.ck_L[ck]; (void)T;
#define STAGE_END   if (ctr + 1 < pe) { XcdBarrier bar_; bar_.bar = P.ctl; bar_.x = xb_xcc_id(); bar_.st = xbw; xcd_barrier<false>(bar_); } } ++ctr;
#define FOR_ITEMS(n, call) for (long it_ = gtid, n_ = (n); it_ < n_; it_ += gstride) { call; }

    STAGE_BEGIN(0)
        dev_prologue_weights(P, (LAS float*)lds, tid_);
        dev_quant_uv(P, tid_);
        FOR_ITEMS((long)cf.nseq_total * 1024, it_siluc(P, it_))
        FOR_ITEMS(cf.depth, it_lam(P, (int)it_))
        FOR_ITEMS((long)cf.depth * 2 * cf.Lmax * 64, it_hid1(P, it_))
        FOR_ITEMS((long)cf.depth * 16 * 128 * 128, it_keys_bf(P, it_))
        FOR_ITEMS((long)cf.depth * 16 * 1024, it_wdt(P, it_))
    STAGE_END
    STAGE_BEGIN(1)
        FOR_ITEMS((long)cf.depth * 2 * cf.Lmax * 64, it_hid2(P, it_))
        dev_ada(P, (LAS float*)lds, tid_);
        dev_quant_wrows(P, tid_);
    STAGE_END
    STAGE_BEGIN(2)
        dev_filt(P, tid_);
    STAGE_END
    STAGE_BEGIN(3)
        FOR_ITEMS((long)cf.depth * 2 * 64 * 1024, it_fsum(P, it_))
    STAGE_END
    STAGE_BEGIN(21)
        dev_gt(P, gtid, gstride);
    STAGE_END

    for (int ck = 0; ck < n_chunks; ++ck) {
        STAGE_BEGIN_C(4)
            dev_norm(P, ck, 0, 0, tid_);
        STAGE_END
        for (int l = 0; l < depth; ++l) {
            STAGE_BEGIN_C(5) {
                { pg8::Gemm g{P.H, P.wcat_t + (size_t)l * NCAT * DM, T, NPROJ, DM, DM, nullptr, nullptr}; pg8::StaticOrder S; S.init(T, NPROJ, gridDim.x, blockIdx.x);
                  pg8::EpiCat E{P.PROJ, (unsigned char*)P.GATES, P.in[IN_B_GATE] + (size_t)l * 4096, 0, nullptr, nullptr};
                  pg8::gemm_phase<pg8::EpiCat, pg8::StaticOrder, false>((PG8_LAS unsigned char*)lds, g, S, E, tid_); }
                { pg8::Gemm g{(const bf16_t*)P.HQ, (const bf16_t*)(P.WG8 + (size_t)l * 4096 * DM), T, 4096, DM / 2, DM / 2, P.HS, P.WGS + (size_t)l * 4096}; pg8::StaticOrder S; S.init(T, 4096, gridDim.x, blockIdx.x);
                  pg8::EpiCat E{P.PROJ, (unsigned char*)P.GATES, P.in[IN_B_GATE] + (size_t)l * 4096, 12, P.HS, P.WGS + (size_t)l * 4096};
                  pg8::gemm_phase<pg8::EpiCat, pg8::StaticOrder, true>((PG8_LAS unsigned char*)lds, g, S, E, tid_); }
                dev_dt(P, ck, l, tid_);
            } STAGE_END
            STAGE_BEGIN_C(6)
                dev_pre_tiles(P, ck, l, (LAS unsigned short*)lds, tid_);
                dev_scan_tiles(P, ck, l, (LAS unsigned short*)lds, tid_);
                FOR_ITEMS((long)T * 16, it_qknorm(P, l, it_))
                dev_cum(P, ck, l, tid_);
            STAGE_END
            STAGE_BEGIN_C(7)
                dev_scan_state<0>(P, ck, l, tid_);
                dev_scan_state<1>(P, ck, l, tid_);
                dev_attn(P, ck, l, (LAS unsigned char*)lds, tid_);
                dev_hyena(P, ck, l, 0, (LAS unsigned char*)lds, tid_);
            STAGE_END
            STAGE_BEGIN_C(8)
                FOR_ITEMS((long)2 * cf.ck_nseq[ck] * 4 * 32 * 64, it_scan_prefix(P, ck, 0, it_))
                FOR_ITEMS((long)2 * cf.ck_nseq[ck] * 4 * 64 * 64, it_scan_prefix(P, ck, 1, it_))
                dev_hyena(P, ck, l, 1, (LAS unsigned char*)lds, tid_);
            STAGE_END
            STAGE_BEGIN_C(18)
                dev_hyout_tiles(P, ck, (LAS unsigned short*)lds, tid_);
                dev_scan_out<0>(P, ck, l, tid_);
                dev_scan_out<1>(P, ck, l, tid_);
                __syncthreads();
                dev_scan_post(P, ck, l, tid_);
            STAGE_END
            STAGE_BEGIN_C(9) {
                pg8::Gemm g{P.YS, P.wbr_t + (size_t)l * 4096 * 256, T, 4096, 256, DM, nullptr, nullptr}; pg8::BranchOrder S; S.init(T, gridDim.x, blockIdx.x);
                pg8::EpiBranch E{P.MRG32, P.MRG, (const unsigned char*)P.GATES};
                pg8::gemm_phase((PG8_LAS unsigned char*)lds, g, S, E, tid_);
            } STAGE_END
            STAGE_BEGIN_C(10) {
                pg8::Gemm g{P.MRG, P.wout_t + (size_t)l * DM * DM, T, DM, DM, DM, nullptr, nullptr}; pg8::StaticOrder S; S.init(T, DM, gridDim.x, blockIdx.x);
                pg8::EpiOut E{l == 0 ? P.in[IN_X_PROMPT] : nullptr, l == 0 ? P.in[IN_X_SAMPLE] : nullptr, P.XB, P.ada + (size_t)l * cf.nseq_total * 6144, cf.ck_tok0[ck], cf.ck_seq0[ck], cf.ck_L[ck], cf.n_prompt_tok};
                pg8::gemm_phase((PG8_LAS unsigned char*)lds, g, S, E, tid_);
            } STAGE_END
            STAGE_BEGIN_C(11)
                dev_norm(P, ck, l, 1, tid_);
            STAGE_END
            STAGE_BEGIN_C(12) {
                pg8::Gemm g{(const bf16_t*)P.HQ, (const bf16_t*)(P.WQ8 + (size_t)l * 2048 * DM), T, 2048, DM / 2, DM / 2, P.HS, P.WQS + (size_t)l * 2048}; pg8::StaticOrder S; S.init(T, 2048, gridDim.x, blockIdx.x);
                pg8::EpiQ E{P.PROJ, P.in[IN_PEER_BQ] + (size_t)l * 2048, P.HS, P.WQS + (size_t)l * 2048};
                pg8::gemm_phase<pg8::EpiQ, pg8::StaticOrder, true>((PG8_LAS unsigned char*)lds, g, S, E, tid_);
                __syncthreads();
                dev_peer_topk(P, ck, l, tid_);
            } STAGE_END
            STAGE_BEGIN_C(15)
                dev_peer(P, ck, l, tid_);
            STAGE_END
        }
    }
}
#endif

static inline size_t al256(size_t x) { return (x + 255) & ~(size_t)255; }
static size_t build_params(Params& P, void* const* d_in, void* d_out, void* d_ws, int depth, int B1, int L1, int B2, int L2, int chunk_tok) {
    memset(&P, 0, sizeof(P));
    for (int i = 0; i < N_INPUTS; ++i) P.in[i] = (const float*)d_in[i];
    P.out = (float*)d_out;
    Cfg& c = P.cfg;
    c.depth = depth; c.nseq_total = B1 + B2; c.n_prompt_seq = B1; c.n_prompt_tok = B1 * L1; c.L_len[0] = L1; c.L_len[1] = L2; c.Lmax = L1 > L2 ? L1 : L2;
    int nc = 0, tmax = 0;
    { const int per = chunk_tok / L1 > 0 ? chunk_tok / L1 : 1; for (int s = 0; s < B1; s += per) { const int n = (B1 - s) < per ? (B1 - s) : per; c.ck_tok0[nc] = s * L1; c.ck_nseq[nc] = n; c.ck_L[nc] = L1; c.ck_seq0[nc] = s; c.ck_li[nc] = 0; if (n * L1 > tmax) tmax = n * L1; ++nc; } }
    { const int per = chunk_tok / L2 > 0 ? chunk_tok / L2 : 1; for (int s = 0; s < B2; s += per) { const int n = (B2 - s) < per ? (B2 - s) : per; c.ck_tok0[nc] = B1 * L1 + s * L2; c.ck_nseq[nc] = n; c.ck_L[nc] = L2; c.ck_seq0[nc] = B1 + s; c.ck_li[nc] = 1; if (n * L2 > tmax) tmax = n * L2; ++nc; } }
    c.n_chunks = nc; c.Tmax = tmax;
    unsigned char* ws = (unsigned char*)d_ws; size_t off = 0;
    auto take = [&](size_t bytes) { unsigned char* p = ws + off; off = al256(off + bytes); return p; };
    P.ctl = (unsigned*)take(65536);
    P.ada = (float*)take((size_t)depth * c.nseq_total * 6144 * 4);
    P.lam = (float*)take(256);
    P.hid1 = (float*)take((size_t)depth * 2 * c.Lmax * 64 * 4);
    P.hid2 = (float*)take((size_t)depth * 2 * c.Lmax * 64 * 4);
    P.filt = (float*)take((size_t)depth * (L1 + L2) * 1024 * 4);
    P.wcat_t = (bf16_t*)take((size_t)depth * NCAT * DM * 2);
    P.wbr_t = (bf16_t*)take((size_t)depth * 4096 * 256 * 2);
    P.wout_t = (bf16_t*)take((size_t)depth * DM * DM * 2);
    P.wq_t = (bf16_t*)take((size_t)depth * 2048 * DM * 2);
    const size_t T = tmax;
    P.H = (bf16_t*)take(T * DM * 2); P.PROJ = (bf16_t*)take(T * NPROJ * 2); P.GATES = (bf16_t*)take(T * 4096 * 2);
    P.HYU = nullptr; P.HYT = (bf16_t*)take(T * 768 * 2); P.VT = (bf16_t*)take(T * 256 * 2); P.GT = (bf16_t*)take((size_t)depth * 512 * (2 * (size_t)(L1 + L2) + 64) * 2); P.HYZ = (bf16_t*)take(T * 256 * 2); P.XBC = (bf16_t*)take(T * 512 * 2); P.YS = (bf16_t*)take(T * DM * 2); P.MRG = (bf16_t*)take(T * DM * 2);
    P.DT = (float*)take(T * 8 * 4); P.RETY = (float*)take(2 * T * 256 * 4); P.SSDY = (float*)take(2 * T * 256 * 4); P.ATTO = nullptr; P.XB = (bf16_t*)take(T * DM * 2); P.DT2 = (float*)take(T * 8 * 4);
    P.MRG32 = nullptr; P.PG = (float*)take(T * 128 * 4); P.PIDX = (int*)take(T * 128 * 4);
    P.CUM = (float*)take(16 * T * 4); P.DTS = (float*)take(8 * T * 4); P.CSR = (float*)take(2 * (T / SCK) * 4 * 32 * 64 * 4); P.CSS = (float*)take(2 * (T / SCK) * 4 * 64 * 64 * 4);
    P.HBR = (bf16_t*)take(2 * (T / SCK) * 4 * 32 * 64 * 2); P.HBS = (bf16_t*)take(2 * (T / SCK) * 4 * 64 * 64 * 2); P.RKT = (bf16_t*)take(T * 128 * 2); P.RVT = (bf16_t*)take(T * 256 * 2); P.XT = (bf16_t*)take(T * 384 * 2);
    P.fsum = (float*)take((size_t)depth * 2 * 64 * 1024 * 4); P.PU = (unsigned char*)take((size_t)depth * 16384 * 2048); P.PV = P.PU + 1024; P.PUs = (float*)take((size_t)depth * 16384 * 4); P.PVs = (float*)take((size_t)depth * 16384 * 4);
    P.keys_t = (float*)take((size_t)depth * 16 * 128 * 128 * 4); P.silu_c = (float*)take((size_t)c.nseq_total * DM * 4); P.keys_bf = (bf16_t*)take((size_t)depth * 16 * 128 * 128 * 2); P.WDT = (bf16_t*)take((size_t)depth * 16 * 1024 * 2);
    P.HQ = (signed char*)take(T * DM); P.HS = (float*)take(T * 4); P.WG8 = (signed char*)take((size_t)depth * 4096 * DM); P.WGS = (float*)take((size_t)depth * 4096 * 4); P.WQ8 = (signed char*)take((size_t)depth * 2048 * DM); P.WQS = (float*)take((size_t)depth * 2048 * 4);
    P.pb = 0; P.pe = 1 << 30;
    return off;
}

#ifndef HOST_TEST
#ifndef MK_MULTI_LAUNCH
#define MK_MULTI_LAUNCH 0
#endif
extern "C" void kernel_launch(void* const* d_in, const int* in_sizes, int n_in, void* d_out, int out_size, void* d_ws, size_t ws_size, hipStream_t stream) {
    static int grid = 0;
    Params P; const size_t need = build_params(P, d_in, d_out, d_ws, 4, 16, 4096, 8, 2048, 16384);
    if (grid == 0) {
        if (n_in != N_INPUTS || ws_size < need) { fprintf(stderr, "kernel_launch: n_in %d ws %zu need %zu\n", n_in, ws_size, need); grid = -1; return; }
        int dev = 0, cus = 0, per_cu = 0;
        if (hipGetDevice(&dev) != hipSuccess || hipDeviceGetAttribute(&cus, hipDeviceAttributeMultiprocessorCount, dev) != hipSuccess) { grid = -1; return; }
        if (hipFuncSetAttribute((const void*)fwd_kernel, hipFuncAttributeMaxDynamicSharedMemorySize, LDS_BYTES) != hipSuccess) { fprintf(stderr, "kernel_launch: hipFuncSetAttribute failed\n"); grid = -1; return; }
        if (hipOccupancyMaxActiveBlocksPerMultiprocessor(&per_cu, (const void*)fwd_kernel, NTHREADS, LDS_BYTES) != hipSuccess || per_cu < 1) fprintf(stderr, "kernel_launch: occupancy query says %d\n", per_cu);
        (void)hipGetLastError();
        grid = cus;
    }
    if (grid < 0) return;
    if (hipMemsetAsync(P.ctl, 0, 65536, stream) != hipSuccess) return;
#if MK_MULTI_LAUNCH
    const int n_stage = 5 + P.cfg.n_chunks * (1 + P.cfg.depth * 12);
    for (int s = 0; s < n_stage; ++s) { P.pb = s; P.pe = s + 1; hipLaunchKernelGGL(fwd_kernel, dim3(grid), dim3(NTHREADS), LDS_BYTES, stream, P); }
#else
    hipLaunchKernelGGL(fwd_kernel, dim3(grid), dim3(NTHREADS), LDS_BYTES, stream, P);
#endif
    const hipError_t le = hipPeekAtLastError();
    if (le != hipSuccess) fprintf(stderr, "kernel_launch: launch failed: %s\n", hipGetErrorName(le));
}
#endif
```
